# Optimizing an MI355X kernel written in HIP

```python
import math
import jax, jax.numpy as jnp
from jax import lax
import numpy as np

D_MODEL = 2048
BATCH = 2
SEQ = 8192
DEPTH = 2

N_EVEN = (DEPTH + 1) // 2
N_ODD = DEPTH // 2
DEEPNORM_ALPHA = (2.0 * DEPTH) ** 0.25
DEEPNORM_BETA = (8.0 * DEPTH) ** -0.25
LN_EPS = 1e-5

DIFF_HEADS = 8
DIFF_HEAD_DIM = 64
DIFF_WIDTH = DIFF_HEADS * 2 * DIFF_HEAD_DIM
DIFF_Q_BLOCK = 128

SSM_INNER = D_MODEL // 2
SSM_HEAD_DIM = 64
SSM_HEADS = SSM_INNER // SSM_HEAD_DIM
SSM_GROUPS = 2
SSM_STATE = 128
SSM_CONV = 4
SSM_CHUNK = 128
SSM_CONV_CH = SSM_INNER + 2 * SSM_GROUPS * SSM_STATE
EVEN_IN = 3 * DIFF_WIDTH + SSM_INNER + SSM_CONV_CH + SSM_HEADS
EVEN_MIX = DIFF_WIDTH + SSM_INNER

NSA_HEADS = 16
NSA_KV_GROUPS = 4
NSA_REP = NSA_HEADS // NSA_KV_GROUPS
NSA_HEAD_DIM = 128
NSA_CMP_LEN = 32
NSA_CMP_STRIDE = 16
NSA_CMP_HIDDEN = 128
NSA_SEL_LEN = 64
NSA_SEL_COUNT = 16
NSA_WINDOW = 512
NSA_Q_BLOCK = 64
NSA_Q_WIDTH = NSA_HEADS * NSA_HEAD_DIM
NSA_KV_WIDTH = NSA_KV_GROUPS * NSA_HEAD_DIM
ODD_IN = NSA_Q_WIDTH + 6 * NSA_KV_WIDTH + 3 * NSA_HEADS
ODD_MIX = NSA_Q_WIDTH

MOE_GROUPS = 8
MOE_PER_GROUP = 4
MOE_EXPERTS = MOE_GROUPS * MOE_PER_GROUP
MOE_TOPK = 2
MOE_FF = 1024
MOE_ROW_BLOCK = 128

NEG = -1e30
BIG = 1e30

kernel_name = "hybrid_diffattn_ssd_nsa_grouped_moe"


def layer_norm(x, g, b):
    xf = x.astype(jnp.float32)
    mu = jnp.mean(xf, -1, keepdims=True)
    var = jnp.mean(jnp.square(xf - mu), -1, keepdims=True)
    return ((xf - mu) * lax.rsqrt(var + LN_EPS) * g + b).astype(x.dtype)


def rms_norm(x, g, eps=1e-5):
    xf = x.astype(jnp.float32)
    y = xf * lax.rsqrt(jnp.mean(xf * xf, -1, keepdims=True) + eps)
    return (y * g).astype(x.dtype)


def masked_softmax(s, mask):
    s = jnp.where(mask, s, -jnp.inf)
    m = jnp.max(s, -1, keepdims=True)
    m = jnp.where(jnp.isfinite(m), m, 0.0)
    e = jnp.exp(s - m)
    den = jnp.sum(e, -1, keepdims=True)
    return e / jnp.where(den > 0, den, 1.0)


def diff_attention(q, k, v, lam, lam_init, subln_g):
    b, s = q.shape[:2]
    nb = s // DIFF_Q_BLOCK
    scale = DIFF_HEAD_DIM ** -0.5
    kpos = jnp.arange(s)

    def one_block(i):
        q0 = i * DIFF_Q_BLOCK
        qb = lax.dynamic_slice_in_dim(q, q0, DIFF_Q_BLOCK, axis=1)
        sc = jnp.einsum('bqhcd,bkhcd->bhcqk', qb, k, preferred_element_type=jnp.float32) * scale
        qpos = q0 + jnp.arange(DIFF_Q_BLOCK)
        causal = kpos[None, :] <= qpos[:, None]
        p = jax.nn.softmax(jnp.where(causal, sc, -jnp.inf), axis=-1)
        a = p[:, :, 0] - lam * p[:, :, 1]
        return jnp.einsum('bhqk,bkhd->bqhd', a.astype(v.dtype), v)

    o = lax.map(one_block, jnp.arange(nb))
    o = jnp.moveaxis(o, 0, 1).reshape(b, s, DIFF_HEADS, 2 * DIFF_HEAD_DIM)
    o = rms_norm(o, subln_g) * (1.0 - lam_init)
    return o.reshape(b, s, DIFF_WIDTH)


def causal_depthwise_conv(x, w, bias):
    c = x.shape[-1]
    y = lax.conv_general_dilated(x, w[:, None, :].astype(x.dtype), window_strides=(1,),
                                 padding=[(SSM_CONV - 1, 0)],
                                 dimension_numbers=('NWC', 'WIO', 'NWC'),
                                 feature_group_count=c)
    return y + bias


def segsum_exp(a):
    l = a.shape[-1]
    cs = jnp.cumsum(a, -1)
    diff = cs[..., :, None] - cs[..., None, :]
    mask = jnp.tril(jnp.ones((l, l), bool))
    return jnp.exp(jnp.where(mask, diff, -jnp.inf))


def ssd_chunked(x, dt, a, bm, cm):
    b, s = x.shape[:2]
    nc = s // SSM_CHUNK
    L = SSM_CHUNK
    J = SSM_HEADS // SSM_GROUPS
    xd = (x.astype(jnp.float32) * dt[..., None]).reshape(b, nc, L, SSM_GROUPS, J, SSM_HEAD_DIM)
    adt = jnp.transpose((dt * a).reshape(b, nc, L, SSM_GROUPS, J), (0, 3, 4, 1, 2))
    bc = bm.astype(jnp.float32).reshape(b, nc, L, SSM_GROUPS, SSM_STATE)
    cc = cm.astype(jnp.float32).reshape(b, nc, L, SSM_GROUPS, SSM_STATE)
    a_cum = jnp.cumsum(adt, -1)
    cb = jnp.einsum('bclgn,bcsgn->bgcls', cc, bc)
    w = cb[:, :, None] * segsum_exp(adt)
    y_diag = jnp.einsum('bgjcls,bcsgjp->bclgjp', w, xd)
    decay_states = jnp.exp(a_cum[..., -1:] - a_cum)
    states = jnp.einsum('bclgn,bgjcl,bclgjp->cbgjpn', bc, decay_states, xd)
    chunk_decay = jnp.moveaxis(jnp.exp(a_cum[..., -1]), -1, 0)

    def step(h, inp):
        dec, st = inp
        return h * dec[..., None, None] + st, h

    h0 = jnp.zeros(states.shape[1:], jnp.float32)
    _, prev = lax.scan(step, h0, (chunk_decay, states))
    y_off = jnp.einsum('bclgn,cbgjpn,bgjcl->bclgjp', cc, prev, jnp.exp(a_cum))
    return (y_diag + y_off).reshape(b, s, SSM_HEADS, SSM_HEAD_DIM)


def mamba2_mixer(z, xbc, dt_raw, conv_w, conv_b, dt_bias, a_log, d_skip, norm_g):
    b, s, _ = z.shape
    xbc = jax.nn.silu(causal_depthwise_conv(xbc, conv_w, conv_b))
    xs, bm, cm = jnp.split(xbc, [SSM_INNER, SSM_INNER + SSM_GROUPS * SSM_STATE], axis=-1)
    xs = xs.reshape(b, s, SSM_HEADS, SSM_HEAD_DIM)
    bm = bm.reshape(b, s, SSM_GROUPS, SSM_STATE)
    cm = cm.reshape(b, s, SSM_GROUPS, SSM_STATE)
    dt = jax.nn.softplus(dt_raw.astype(jnp.float32) + dt_bias.astype(jnp.float32))
    a = -jnp.exp(a_log.astype(jnp.float32))
    y = ssd_chunked(xs, dt, a, bm, cm)
    y = y + d_skip.astype(jnp.float32)[:, None] * xs.astype(jnp.float32)
    y = y.reshape(b, s, SSM_INNER) * jax.nn.silu(z.astype(jnp.float32))
    yg = y.reshape(b, s, SSM_GROUPS, SSM_INNER // SSM_GROUPS)
    yg = yg * lax.rsqrt(jnp.mean(yg * yg, -1, keepdims=True) + 1e-5)
    return (yg.reshape(b, s, SSM_INNER) * norm_g).astype(z.dtype)


def even_mixer(x, w_in, w_out, lam_q1, lam_k1, lam_q2, lam_k2, subln_g,
               conv_w, conv_b, dt_bias, a_log, d_skip, ssm_norm_g, lam_init):
    b, s, _ = x.shape
    proj = x @ w_in
    splits = np.cumsum([DIFF_WIDTH] * 4 + [SSM_CONV_CH]).tolist()
    q, k, v, z, xbc, dt_raw = jnp.split(proj, splits, axis=-1)
    q = q.reshape(b, s, DIFF_HEADS, 2, DIFF_HEAD_DIM)
    k = k.reshape(b, s, DIFF_HEADS, 2, DIFF_HEAD_DIM)
    v = v.reshape(b, s, DIFF_HEADS, 2 * DIFF_HEAD_DIM)
    lam = (jnp.exp(jnp.sum(lam_q1.astype(jnp.float32) * lam_k1))
           - jnp.exp(jnp.sum(lam_q2.astype(jnp.float32) * lam_k2)) + lam_init)
    y_attn = diff_attention(q, k, v, lam, lam_init, subln_g)
    y_ssm = mamba2_mixer(z, xbc, dt_raw, conv_w, conv_b, dt_bias, a_log, d_skip, ssm_norm_g)
    return jnp.concatenate([y_attn, y_ssm], axis=-1) @ w_out


def compress_tokens(kv, pe, w1, w2):
    b, s, g, d = kv.shape
    nc = (s - NSA_CMP_LEN) // NSA_CMP_STRIDE + 1
    idx = jnp.arange(nc)[:, None] * NSA_CMP_STRIDE + jnp.arange(NSA_CMP_LEN)[None, :]
    blocks = kv[:, idx] + pe[:, None, :]
    blocks = jnp.moveaxis(blocks, 3, 2).reshape(b, nc, g, NSA_CMP_LEN * d)
    return jax.nn.gelu(blocks @ w1) @ w2


def cmp_to_sel_overlap(nc, ns):
    cs = jnp.arange(nc) * NSA_CMP_STRIDE
    ss = jnp.arange(ns) * NSA_SEL_LEN
    lo = jnp.maximum(cs[:, None], ss[None, :])
    hi = jnp.minimum(cs[:, None] + NSA_CMP_LEN, ss[None, :] + NSA_SEL_LEN)
    return jnp.maximum(hi - lo, 0).astype(jnp.float32) / NSA_CMP_LEN


def nsa_attention(q, k_cmp, v_cmp, k_sel, v_sel, k_win, v_win, gates):
    b, s = q.shape[:2]
    nc = k_cmp.shape[1]
    ns = s // NSA_SEL_LEN
    n_pick = min(NSA_SEL_COUNT, ns)
    overlap = cmp_to_sel_overlap(nc, ns)
    cmp_end = jnp.arange(nc) * NSA_CMP_STRIDE + NSA_CMP_LEN - 1
    sel_ids = jnp.arange(ns)
    sel_start = sel_ids * NSA_SEL_LEN
    scale = NSA_HEAD_DIM ** -0.5
    ks_g = jnp.moveaxis(k_sel, 2, 1)
    vs_g = jnp.moveaxis(v_sel, 2, 1)
    pad = jnp.zeros((b, NSA_WINDOW) + k_win.shape[2:], k_win.dtype)
    kw_p = jnp.concatenate([pad, k_win], axis=1)
    vw_p = jnp.concatenate([pad, v_win], axis=1)
    gather = jax.vmap(jax.vmap(lambda tab, ii: tab[ii]))
    offs = jnp.arange(NSA_SEL_LEN)
    nwin = NSA_WINDOW + NSA_Q_BLOCK

    def one_block(i):
        q0 = i * NSA_Q_BLOCK
        qb = lax.dynamic_slice_in_dim(q, q0, NSA_Q_BLOCK, axis=1)
        gb = lax.dynamic_slice_in_dim(gates, q0, NSA_Q_BLOCK, axis=1)
        t = q0 + jnp.arange(NSA_Q_BLOCK)
        sc = jnp.einsum('bqgrd,bngd->bgrqn', qb, k_cmp, preferred_element_type=jnp.float32) * scale
        p_cmp = masked_softmax(sc, cmp_end[None, :] <= t[:, None])
        o_cmp = jnp.einsum('bgrqn,bngd->bqgrd', p_cmp.astype(v_cmp.dtype), v_cmp)
        imp = jnp.einsum('bgrqn,nm->bgqm', p_cmp, overlap)
        cur = t // NSA_SEL_LEN
        valid = sel_start[None, :] <= t[:, None]
        forced = ((sel_ids[None, :] == 0) | (sel_ids[None, :] == cur[:, None])
                  | (sel_ids[None, :] == cur[:, None] - 1))
        imp = jnp.where(valid, jnp.where(forced, BIG, imp), NEG)
        _, top = lax.top_k(imp, n_pick)
        tok = (top[..., None] * NSA_SEL_LEN + offs).reshape(b, NSA_KV_GROUPS, NSA_Q_BLOCK, n_pick * NSA_SEL_LEN)
        kg = gather(ks_g, tok)
        vg = gather(vs_g, tok)
        ss = jnp.einsum('bqgrd,bgqkd->bgrqk', qb, kg, preferred_element_type=jnp.float32) * scale
        p_sel = masked_softmax(ss, (tok <= t[:, None])[:, :, None])
        o_sel = jnp.einsum('bgrqk,bgqkd->bqgrd', p_sel.astype(vg.dtype), vg)
        kw = lax.dynamic_slice_in_dim(kw_p, q0, nwin, axis=1)
        vw = lax.dynamic_slice_in_dim(vw_p, q0, nwin, axis=1)
        kpos = q0 - NSA_WINDOW + jnp.arange(nwin)
        wmask = ((kpos[None, :] <= t[:, None]) & (kpos[None, :] > t[:, None] - NSA_WINDOW)
                 & (kpos[None, :] >= 0))
        sw = jnp.einsum('bqgrd,bkgd->bgrqk', qb, kw, preferred_element_type=jnp.float32) * scale
        p_win = masked_softmax(sw, wmask)
        o_win = jnp.einsum('bgrqk,bkgd->bqgrd', p_win.astype(vw.dtype), vw)
        return gb[..., 0:1] * o_cmp + gb[..., 1:2] * o_sel + gb[..., 2:3] * o_win

    o = lax.map(one_block, jnp.arange(s // NSA_Q_BLOCK))
    return jnp.moveaxis(o, 0, 1).reshape(b, s, NSA_HEADS * NSA_HEAD_DIM)


def odd_mixer(x, w_in, w_out, pe_k, pe_v, ck_w1, ck_w2, cv_w1, cv_w2):
    b, s, _ = x.shape
    proj = x @ w_in
    splits = np.cumsum([NSA_Q_WIDTH] + [NSA_KV_WIDTH] * 6).tolist()
    q, kc, vc, ks, vs, kw, vw, g = jnp.split(proj, splits, axis=-1)
    q = q.reshape(b, s, NSA_KV_GROUPS, NSA_REP, NSA_HEAD_DIM)
    kvr = lambda a: a.reshape(b, s, NSA_KV_GROUPS, NSA_HEAD_DIM)
    k_cmp = compress_tokens(kvr(kc), pe_k, ck_w1, ck_w2)
    v_cmp = compress_tokens(kvr(vc), pe_v, cv_w1, cv_w2)
    gates = jax.nn.sigmoid(g.astype(jnp.float32)).reshape(b, s, NSA_KV_GROUPS, NSA_REP, 3).astype(x.dtype)
    o = nsa_attention(q, k_cmp, v_cmp, kvr(ks), kvr(vs), kvr(kw), kvr(vw), gates)
    return o @ w_out


def route(h, router_w, router_b):
    s = jax.nn.sigmoid(jnp.dot(h, router_w, preferred_element_type=jnp.float32))
    biased = (s + router_b.astype(jnp.float32)).reshape(-1, MOE_GROUPS, MOE_PER_GROUP)
    top_val, top_idx = lax.top_k(biased, MOE_TOPK)
    grp = jnp.argmax(jnp.sum(top_val, -1), axis=-1)
    local = jnp.take_along_axis(top_idx, grp[:, None, None], axis=1)[:, 0]
    expert = grp[:, None] * MOE_PER_GROUP + local
    w = jnp.take_along_axis(s, expert, axis=1)
    return expert.astype(jnp.int32), w / jnp.sum(w, -1, keepdims=True)


def moe_ffn(h, router_w, router_b, w_gate, w_up, w_down):
    t, d = h.shape
    expert, gate = route(h, router_w, router_b)
    tk = t * MOE_TOPK
    m = MOE_ROW_BLOCK
    n_blocks = -(-tk // m) + MOE_EXPERTS
    rows = n_blocks * m
    flat_e = expert.reshape(-1)
    flat_tok = jnp.arange(tk, dtype=jnp.int32) // MOE_TOPK
    order = jnp.argsort(flat_e)
    sorted_e = flat_e[order]
    counts = jnp.zeros((MOE_EXPERTS,), jnp.int32).at[flat_e].add(1)
    padded = (counts + m - 1) // m * m
    pad_end = jnp.cumsum(padded)
    start = jnp.cumsum(counts) - counts
    dest = (pad_end - padded)[sorted_e] + jnp.arange(tk, dtype=jnp.int32) - start[sorted_e]
    buf_tok = jnp.full((rows,), t, jnp.int32).at[dest].set(flat_tok[order])
    buf_w = jnp.zeros((rows,), h.dtype).at[dest].set(gate.reshape(-1)[order].astype(h.dtype))
    block_e = jnp.minimum(jnp.searchsorted(pad_end, jnp.arange(n_blocks, dtype=jnp.int32) * m, side='right'),
                          MOE_EXPERTS - 1)
    xg = jnp.concatenate([h, jnp.zeros((1, d), h.dtype)], axis=0)[buf_tok].reshape(n_blocks, m, d)

    def expert_block(args):
        xb, e = args
        hid = jax.nn.silu(xb @ w_gate[e]) * (xb @ w_up[e])
        return hid @ w_down[e]

    yb = lax.map(expert_block, (xg, block_e)).reshape(rows, d)
    return jax.ops.segment_sum(yb * buf_w[:, None], buf_tok, num_segments=t + 1)[:t]


def setup_inputs(seed: int = 0) -> dict:
    key = jax.random.key(seed)
    keys = iter(jax.random.split(key, 64))
    nrm = lambda shape, sc: jax.random.normal(next(keys), shape, jnp.float32) * sc
    dt = jnp.exp(jax.random.uniform(next(keys), (N_EVEN, SSM_HEADS), jnp.float32)
                 * (math.log(0.1) - math.log(1e-3)) + math.log(1e-3))
    dt = jnp.maximum(dt, 1e-4)
    return {
        "x": nrm((BATCH, SEQ, D_MODEL), 1.0),
        "router_w": nrm((D_MODEL, MOE_EXPERTS), D_MODEL ** -0.5),
        "router_b": nrm((MOE_EXPERTS,), 0.01),
        "even_w_in": nrm((N_EVEN, D_MODEL, EVEN_IN), D_MODEL ** -0.5),
        "even_w_out": nrm((N_EVEN, EVEN_MIX, D_MODEL), DEEPNORM_BETA * EVEN_MIX ** -0.5),
        "diff_lam_q1": nrm((N_EVEN, DIFF_HEAD_DIM), 0.1),
        "diff_lam_k1": nrm((N_EVEN, DIFF_HEAD_DIM), 0.1),
        "diff_lam_q2": nrm((N_EVEN, DIFF_HEAD_DIM), 0.1),
        "diff_lam_k2": nrm((N_EVEN, DIFF_HEAD_DIM), 0.1),
        "diff_subln_g": 1.0 + nrm((N_EVEN, 2 * DIFF_HEAD_DIM), 0.02),
        "ssm_conv_w": nrm((N_EVEN, SSM_CONV, SSM_CONV_CH), SSM_CONV ** -0.5),
        "ssm_conv_b": nrm((N_EVEN, SSM_CONV_CH), 0.02),
        "ssm_dt_bias": dt + jnp.log(-jnp.expm1(-dt)),
        "ssm_a_log": jnp.log(jax.random.uniform(next(keys), (N_EVEN, SSM_HEADS), jnp.float32, 1.0, 16.0)),
        "ssm_d": 1.0 + nrm((N_EVEN, SSM_HEADS), 0.02),
        "ssm_norm_g": 1.0 + nrm((N_EVEN, SSM_INNER), 0.02),
        "odd_w_in": nrm((N_ODD, D_MODEL, ODD_IN), D_MODEL ** -0.5),
        "odd_w_out": nrm((N_ODD, ODD_MIX, D_MODEL), DEEPNORM_BETA * ODD_MIX ** -0.5),
        "nsa_pe_k": nrm((N_ODD, NSA_CMP_LEN, NSA_HEAD_DIM), 0.1),
        "nsa_pe_v": nrm((N_ODD, NSA_CMP_LEN, NSA_HEAD_DIM), 0.1),
        "nsa_ck_w1": nrm((N_ODD, NSA_CMP_LEN * NSA_HEAD_DIM, NSA_CMP_HIDDEN), (NSA_CMP_LEN * NSA_HEAD_DIM) ** -0.5),
        "nsa_ck_w2": nrm((N_ODD, NSA_CMP_HIDDEN, NSA_HEAD_DIM), NSA_CMP_HIDDEN ** -0.5),
        "nsa_cv_w1": nrm((N_ODD, NSA_CMP_LEN * NSA_HEAD_DIM, NSA_CMP_HIDDEN), (NSA_CMP_LEN * NSA_HEAD_DIM) ** -0.5),
        "nsa_cv_w2": nrm((N_ODD, NSA_CMP_HIDDEN, NSA_HEAD_DIM), NSA_CMP_HIDDEN ** -0.5),
        "ln_mix_g": 1.0 + nrm((DEPTH, D_MODEL), 0.02),
        "ln_mix_b": nrm((DEPTH, D_MODEL), 0.02),
        "ln_ffn_g": 1.0 + nrm((DEPTH, D_MODEL), 0.02),
        "ln_ffn_b": nrm((DEPTH, D_MODEL), 0.02),
        "moe_w_gate": nrm((DEPTH, MOE_EXPERTS, D_MODEL, MOE_FF), D_MODEL ** -0.5),
        "moe_w_up": nrm((DEPTH, MOE_EXPERTS, D_MODEL, MOE_FF), D_MODEL ** -0.5),
        "moe_w_down": nrm((DEPTH, MOE_EXPERTS, MOE_FF, D_MODEL), DEEPNORM_BETA * MOE_FF ** -0.5),
    }


def reference(x, router_w, router_b, even_w_in, even_w_out, diff_lam_q1, diff_lam_k1, diff_lam_q2,
              diff_lam_k2, diff_subln_g, ssm_conv_w, ssm_conv_b, ssm_dt_bias, ssm_a_log, ssm_d,
              ssm_norm_g, odd_w_in, odd_w_out, nsa_pe_k, nsa_pe_v, nsa_ck_w1, nsa_ck_w2, nsa_cv_w1,
              nsa_cv_w2, ln_mix_g, ln_mix_b, ln_ffn_g, ln_ffn_b, moe_w_gate, moe_w_up, moe_w_down):
    b, s, d = x.shape
    for layer in range(DEPTH):
        i = layer // 2
        if layer % 2 == 0:
            lam_init = 0.8 - 0.6 * math.exp(-0.3 * layer)
            mix = even_mixer(x, even_w_in[i], even_w_out[i], diff_lam_q1[i], diff_lam_k1[i],
                             diff_lam_q2[i], diff_lam_k2[i], diff_subln_g[i], ssm_conv_w[i],
                             ssm_conv_b[i], ssm_dt_bias[i], ssm_a_log[i], ssm_d[i], ssm_norm_g[i],
                             lam_init)
        else:
            mix = odd_mixer(x, odd_w_in[i], odd_w_out[i], nsa_pe_k[i], nsa_pe_v[i], nsa_ck_w1[i],
                            nsa_ck_w2[i], nsa_cv_w1[i], nsa_cv_w2[i])
        h = layer_norm(DEEPNORM_ALPHA * x + mix, ln_mix_g[layer], ln_mix_b[layer])
        f = moe_ffn(h.reshape(b * s, d), router_w, router_b, moe_w_gate[layer], moe_w_up[layer],
                    moe_w_down[layer]).reshape(b, s, d)
        x = layer_norm(DEEPNORM_ALPHA * h + f, ln_ffn_g[layer], ln_ffn_b[layer])
    return x
```

```cpp
#include <hip/hip_runtime.h>
#include <cstdio>
#include <cstdint>

#define GAS __attribute__((address_space(1)))
#define LAS __attribute__((address_space(3)))
typedef unsigned short bf16;
typedef short bf16x8 __attribute__((ext_vector_type(8)));
typedef short s16x4 __attribute__((ext_vector_type(4)));
typedef float f32x2 __attribute__((ext_vector_type(2)));
typedef float f32x4 __attribute__((ext_vector_type(4)));
typedef float f32x16 __attribute__((ext_vector_type(16)));
typedef unsigned u32x2 __attribute__((ext_vector_type(2)));
typedef unsigned u32x4 __attribute__((ext_vector_type(4)));
typedef GAS unsigned gu32;

constexpr int BATCH = 2, SEQ = 8192, DM = 2048, NTOK = BATCH * SEQ;
constexpr float ALPHA = 1.4142135623730951f;
constexpr float LN_EPS = 1e-5f;
constexpr int EVEN_IN = 5648, EVEN_IN_PAD = 5888, ODD_IN = 5168, ODD_MAIN = 5120;
constexpr int NEXP = 32, MOE_FF = 1024;
constexpr int XG_ROWS = 40960;
constexpr int NWAVES = 8, NTHR = 512;
constexpr float LOG2E = 1.4426950408889634f;

constexpr size_t MiB = 1u << 20;
constexpr size_t WS_CTL = 0, CTL_ZERO_BYTES = 1 * MiB;
constexpr size_t WS_WIN0T = 2 * MiB, WS_WOUT0T = 26 * MiB, WS_WIN1T = 34 * MiB, WS_WOUT1T = 54 * MiB, WS_WGT = 62 * MiB, WS_WRT3 = 63 * MiB,
                 WS_W1KT = 64 * MiB, WS_W1VT = 65 * MiB, WS_W2KT = 66 * MiB, WS_W2VT = 66 * MiB + 512 * 1024;
constexpr size_t WS_MOEB1 = 68 * MiB, WS_MOEB2 = 580 * MiB;
constexpr size_t WS_R = 836 * MiB, WS_XB = 964 * MiB, WS_HB = 1028 * MiB, WS_HLO = 1092 * MiB, WS_XG = 1156 * MiB, WS_HID = 1316 * MiB, WS_FOUT = 1396 * MiB;
constexpr size_t WS_TOK = 1524 * MiB;
constexpr size_t WS_MIX = 1526 * MiB;
constexpr size_t MX_Q = 0, MX_K = 32 * MiB, MX_V = 64 * MiB, MX_Z = 96 * MiB, MX_XBC = 128 * MiB, MX_DT = 176 * MiB, MX_OV = 177 * MiB, MX_ST = 241 * MiB, MX_CDEC = 305 * MiB,
                 MX_YSRAW = 306 * MiB, MX_YMIX = 338 * MiB;
constexpr size_t MY_Q = 0, MY_KC = 64 * MiB, MY_VC = 81 * MiB, MY_KS = 98 * MiB, MY_KW = 114 * MiB, MY_VST = 130 * MiB, MY_VWT = 146 * MiB, MY_KCMP = 162 * MiB, MY_VCT = 163 * MiB,
                 MY_GATES = 164 * MiB, MY_ONSA = 167 * MiB;
constexpr size_t WS_END = WS_MIX + 402 * MiB;

constexpr int CW_TMO = 0, CW_CODE = 1;
constexpr int CW_BAR = 4096;
constexpr int CW_CNT = 16384;

constexpr int LDS_BYTES = 147456;
constexpr int RING_BYTES = 131072;
constexpr int LDSCTL_OFF = RING_BYTES;
constexpr int MISC_OFF = LDSCTL_OFF;
constexpr int MOE_TAB_OFF = LDSCTL_OFF + 256;

#define RLX_AGENT __ATOMIC_RELAXED, __HIP_MEMORY_SCOPE_AGENT
#define LDS_WAIT() asm volatile("s_waitcnt lgkmcnt(0)" ::: "memory")
#define VM_WAIT() asm volatile("s_waitcnt vmcnt(0)" ::: "memory")
__device__ __forceinline__ unsigned f2bf(float f) { unsigned u = __builtin_bit_cast(unsigned, f); return (u + 0x7fffu + ((u >> 16) & 1u)) >> 16; }
__device__ __forceinline__ unsigned pk2(float lo, float hi) { return f2bf(lo) | (f2bf(hi) << 16); }
__device__ __forceinline__ float bf2f(unsigned b) { return __builtin_bit_cast(float, b << 16); }
__device__ __forceinline__ float bflo(unsigned w) { return __builtin_bit_cast(float, w << 16); }
__device__ __forceinline__ float bfhi(unsigned w) { return __builtin_bit_cast(float, w & 0xffff0000u); }
__device__ __forceinline__ float wave_sum(float v) {
#pragma unroll
    for (int o = 1; o < 64; o <<= 1) v += __shfl_xor(v, o);
    return v;
}
__device__ __forceinline__ float fast_exp2(float x) { return __builtin_amdgcn_exp2f(x); }
__device__ __forceinline__ float fast_rcp(float x) { return __builtin_amdgcn_rcpf(x); }
__device__ __forceinline__ int crow(int r, int hi) { return (r & 3) + 8 * (r >> 2) + 4 * hi; }
#define ONE_LAUNCH 1
#define ENABLE_MIX0 1
#define ENABLE_MIX1 1
#define PHASE_ACTIVE(layer, k) 1
#define MOE_CVT_IN_ATTN 1
#define MOE_GATHER 1
namespace pg8 {
#define PG8_LAS __attribute__((address_space(3)))
typedef unsigned short bf16_t;
constexpr int BM = 256, BK = 64, HALF = 128, HTB = HALF * BK * 2  , STAGE_BYTES = 8 * HTB, NXCD = 8, WGM = 8;

__host__ __device__ __forceinline__ int lds_byte(int r, int c) { const int st = (r >> 4) * 2 + (c >> 5), rr = r & 15, cc = c & 31, ob = rr * 64 + cc * 2; return st * 1024 + (ob ^ (((ob >> 9) & 1) << 5)); }
__host__ __device__ __forceinline__ void stage_rc(int b, int& R, int& C) { const int st = b / 1024, sb = b % 1024, swz = sb ^ (((sb >> 9) & 1) << 5); R = (st >> 1) * 16 + swz / 64; C = (st & 1) * 32 + (swz % 64) / 2; }
__host__ __device__ __forceinline__ int perm32(int rho) { const int n = rho >> 4, i = rho & 15; return 8 * (i >> 2) + 4 * n + (i & 3); }

struct Unit { int pm, pn; };
struct Gemm { const bf16_t* A; const bf16_t* Bt; int M, N, K; };

struct StaticOrder {
    int nM, nN, nwg, G, c;
    __host__ __device__ void init(int M, int N, int G_, int c_) { nM = M / BM; nN = N / BM; nwg = nM * nN; G = G_; c = c_; }
    __host__ __device__ bool next(int i, Unit& u) const {
        const long L = (long)i * G + c; if (L >= nwg) return false;
        int wgid = (int)L; { const int q = nwg / NXCD, r = nwg % NXCD, xcd = wgid % NXCD, off = wgid / NXCD; wgid = (xcd < r ? xcd * (q + 1) : r * (q + 1) + (xcd - r) * q) + off; }
        const int nig = WGM * nN, gid = wgid / nig, fm = gid * WGM, gsz = (nM - fm) < WGM ? (nM - fm) : WGM;
        u.pm = fm + ((wgid % nig) % gsz); u.pn = (wgid % nig) / gsz; return true;
    }
    __device__ __forceinline__ void a_ready(const Unit&) const {}
    __device__ __forceinline__ void done(const Unit&) const {}
};
__device__ __forceinline__ unsigned cvt_pk_bf16(float lo, float hi) { unsigned r; asm volatile("v_cvt_pk_bf16_f32 %0, %1, %2" : "=v"(r) : "v"(lo), "v"(hi)); return r; }
template <class Epi, class Sched, bool ALIGN_EPI = false, bool SP2 = false, bool GATHER = false>
__device__ __forceinline__ void gemm_phase(PG8_LAS unsigned char* lds, const Gemm g, const Sched& S, const Epi& E, const PG8_LAS unsigned* gtab = nullptr) {
    static_assert(!GATHER || SP2, "the gathered A operand is wired into the SP2 loop only");
    int tid_ = threadIdx.x; asm volatile("" : "+v"(tid_));
    const int tid = tid_, wid = __builtin_amdgcn_readfirstlane(tid >> 6), lane = tid & 63, wr = wid >> 2, wc = wid & 3, fr = lane & 15, fq = lane >> 4;
    const int K = g.K, nt = K / BK;
    unsigned voffA[2], voffB[2], CA2[2]; int RA[2];
#pragma unroll
    for (int i = 0; i < 2; ++i) { int R, C; stage_rc(tid * 16 + i * 8192, R, C); const int Rb = Epi::PERM ? ((R & ~31) + perm32(R & 31)) : R;
        voffA[i] = (unsigned)(R * K + C) * 2u; voffB[i] = (unsigned)(Rb * K + C) * 2u; RA[i] = R; CA2[i] = (unsigned)C * 2u; }
    unsigned offC[2][2] = {{0u, 0u}, {0u, 0u}}, offN[2][2] = {{0u, 0u}, {0u, 0u}}, o2[2][2] = {{0u, 0u}, {0u, 0u}};
#define PG8_GOFF(dst, u) do { _Pragma("unroll") for (int h_ = 0; h_ < 2; ++h_) _Pragma("unroll") for (int i_ = 0; i_ < 2; ++i_) dst[h_][i_] = gtab[(u) * 256 + h_ * HALF + RA[i_]] + CA2[i_]; } while (0)
#define PG8_STA(bufoff, ptr, half, OFFS) do { if constexpr (GATHER) { PG8_STAGE(bufoff, ptr, OFFS[half]); } else { PG8_STAGE(bufoff, (ptr) + (half) * hstep, voffA); } } while (0)
    const size_t kstep = (size_t)(BK * 2);
    const size_t hstep = (size_t)HALF * K * 2;
    const size_t tstep = 2 * hstep;
    const unsigned ldsw = (unsigned)wid * 1024u;
    const int aoff = lds_byte(wr * 64 + fr, fq * 8), boff = lds_byte(wc * 32 + fr, fq * 8);
#define PG8_SA(b, h) (((b) * 2 + (h)) * HTB)
#define PG8_SB(b, h) ((4 + (b) * 2 + (h)) * HTB)
#define PG8_STAGE(bufoff, gbase, voff) do { _Pragma("unroll") for (int _i = 0; _i < 2; ++_i) \
        __builtin_amdgcn_global_load_lds((const unsigned*)((const char*)(gbase) + (voff)[_i]), (PG8_LAS unsigned*)(lds + (bufoff) + ldsw + _i * 8192), 16, 0, 0); } while (0)
#define PG8_LDA(dst, b, h) do { _Pragma("unroll") for (int m = 0; m < 4; ++m) _Pragma("unroll") for (int k = 0; k < 2; ++k) dst[m][k] = *(const PG8_LAS bf16x8*)(lds + PG8_SA(b, h) + aoff + m * 2048 + k * 1024); } while (0)
#define PG8_LDB(dst, b, h) do { _Pragma("unroll") for (int n = 0; n < 2; ++n) _Pragma("unroll") for (int k = 0; k < 2; ++k) dst[n][k] = *(const PG8_LAS bf16x8*)(lds + PG8_SB(b, h) + boff + n * 2048 + k * 1024); } while (0)
#define PG8_MMA(ai, bj, At, Bt) do { __builtin_amdgcn_s_setprio(1); _Pragma("unroll") for (int m = 0; m < 4; ++m) _Pragma("unroll") for (int n = 0; n < 2; ++n) _Pragma("unroll") for (int k = 0; k < 2; ++k) \
        acc[ai][bj][m][n] = __builtin_amdgcn_mfma_f32_16x16x32_bf16(Bt[n][k], At[m][k], acc[ai][bj][m][n], 0, 0, 0); __builtin_amdgcn_s_setprio(0); } while (0)
#define PG8_WAIT_V(n) asm volatile("s_waitcnt vmcnt(" #n ")" ::: "memory")
#define PG8_WAIT_L(n) asm volatile("s_waitcnt lgkmcnt(" #n ")" ::: "memory")
#define PG8_BAR __builtin_amdgcn_s_barrier()
#define PG8_SCHED __builtin_amdgcn_sched_barrier(0)
    Unit cur, nxt; int ui = 0;
    if (!S.next(0, cur)) return;
    f32x4 acc[2][2][4][2];
#pragma unroll
    for (int a = 0; a < 2; ++a)
#pragma unroll
        for (int b = 0; b < 2; ++b)
#pragma unroll
            for (int m = 0; m < 4; ++m)
#pragma unroll
                for (int n = 0; n < 2; ++n) acc[a][b][m][n] = (f32x4){0.f, 0.f, 0.f, 0.f};
    bf16x8 At[4][2], B0[2][2], B1[2][2];
    const char* cA = (const char*)g.A + (GATHER ? (size_t)0 : (size_t)cur.pm * tstep); const char* cB = (const char*)g.Bt + (size_t)cur.pn * tstep;
    if constexpr (GATHER) PG8_GOFF(offC, 0);
    S.a_ready(cur);
    if constexpr (SP2) {
        PG8_STAGE(PG8_SB(0, 0), cB, voffB); PG8_STAGE(PG8_SB(0, 1), cB + hstep, voffB); PG8_STA(PG8_SA(0, 0), cA, 0, offC); PG8_STA(PG8_SA(0, 1), cA, 1, offC);
        if (wr == 1) PG8_BAR;
        PG8_WAIT_V(2); PG8_BAR;
        PG8_STAGE(PG8_SB(1, 0), cB + kstep, voffB); PG8_STA(PG8_SA(1, 0), cA + kstep, 0, offC); PG8_STAGE(PG8_SB(1, 1), cB + hstep + kstep, voffB);
        PG8_WAIT_V(6); PG8_BAR;
    } else {
        PG8_STAGE(PG8_SB(0, 0), cB, voffB); PG8_STAGE(PG8_SA(0, 0), cA, voffA); PG8_STAGE(PG8_SB(0, 1), cB + hstep, voffB); PG8_STAGE(PG8_SA(0, 1), cA + hstep, voffA);
        if (wr == 1) PG8_BAR;
        PG8_WAIT_V(4); PG8_BAR;
        PG8_STAGE(PG8_SB(1, 0), cB + kstep, voffB); PG8_STAGE(PG8_SA(1, 0), cA + kstep, voffA); PG8_STAGE(PG8_SB(1, 1), cB + hstep + kstep, voffB);
        PG8_WAIT_V(6); PG8_BAR;
    }
    for (;;) {
        const bool has_next = S.next(ui + 1, nxt);
        const char* nA = (has_next && !GATHER) ? (const char*)g.A + (size_t)nxt.pm * tstep : cA; const char* nB = has_next ? (const char*)g.Bt + (size_t)nxt.pn * tstep : cB;
        if constexpr (GATHER) { if (has_next) PG8_GOFF(offN, ui + 1); }
        for (int t = 0; t < nt; t += 2) {
            const bool last = (t == nt - 2);
            const char* a1 = cA + (size_t)(t + 1) * kstep;
            const char* a2 = last ? nA : cA + (size_t)(t + 2) * kstep; const char* b2 = last ? nB : cB + (size_t)(t + 2) * kstep;
            const char* a3 = a2 + kstep; const char* b3 = b2 + kstep;
            if (last && has_next) S.a_ready(nxt);
            if constexpr (GATHER) {
#pragma unroll
                for (int h_ = 0; h_ < 2; ++h_)
#pragma unroll
                    for (int i_ = 0; i_ < 2; ++i_) o2[h_][i_] = (last && has_next) ? offN[h_][i_] : offC[h_][i_]; }
            if constexpr (SP2) {
            PG8_LDB(B0, 0, 0); PG8_LDB(B1, 0, 1); PG8_SCHED; PG8_LDA(At, 0, 0); PG8_STA(PG8_SA(1, 1), a1, 1, offC);
            PG8_WAIT_V(8); PG8_WAIT_L(0); PG8_BAR; PG8_MMA(0, 0, At, B0); PG8_MMA(0, 1, At, B1); PG8_BAR; PG8_SCHED;
            PG8_LDA(At, 0, 1); PG8_STAGE(PG8_SB(0, 0), b2, voffB); PG8_STAGE(PG8_SB(0, 1), b2 + hstep, voffB); PG8_STA(PG8_SA(0, 0), a2, 0, o2);
            PG8_WAIT_V(8); PG8_WAIT_L(0); PG8_BAR; PG8_MMA(1, 0, At, B0); PG8_MMA(1, 1, At, B1); PG8_BAR; PG8_SCHED;
            PG8_LDB(B0, 1, 0); PG8_LDB(B1, 1, 1); PG8_SCHED; PG8_LDA(At, 1, 0); PG8_STA(PG8_SA(0, 1), a2, 1, o2);
            PG8_WAIT_V(8); PG8_WAIT_L(0); PG8_BAR; PG8_MMA(0, 0, At, B0); PG8_MMA(0, 1, At, B1); PG8_BAR; PG8_SCHED;
            PG8_LDA(At, 1, 1); PG8_STAGE(PG8_SB(1, 0), b3, voffB); PG8_STAGE(PG8_SB(1, 1), b3 + hstep, voffB); PG8_STA(PG8_SA(1, 0), a3, 0, o2);
            PG8_WAIT_V(8); PG8_WAIT_L(0); PG8_BAR; PG8_MMA(1, 0, At, B0); PG8_MMA(1, 1, At, B1); PG8_BAR; PG8_SCHED;
            } else {
            PG8_LDB(B0, 0, 0); PG8_SCHED; PG8_LDA(At, 0, 0); PG8_STAGE(PG8_SA(1, 1), a1 + hstep, voffA);
            PG8_WAIT_L(8); PG8_BAR; PG8_WAIT_L(0); PG8_MMA(0, 0, At, B0); PG8_BAR; PG8_SCHED;
            PG8_LDB(B1, 0, 1); PG8_STAGE(PG8_SB(0, 0), b2, voffB);
            PG8_BAR; PG8_WAIT_L(0); PG8_MMA(0, 1, At, B1); PG8_BAR;
            PG8_LDA(At, 0, 1); PG8_STAGE(PG8_SA(0, 0), a2, voffA);
            PG8_BAR; PG8_WAIT_L(0); PG8_MMA(1, 0, At, B0); PG8_BAR; PG8_SCHED;
            PG8_STAGE(PG8_SB(0, 1), b2 + hstep, voffB);
            PG8_WAIT_V(6); PG8_BAR; PG8_MMA(1, 1, At, B1); PG8_BAR;
            PG8_LDB(B0, 1, 0); PG8_SCHED; PG8_LDA(At, 1, 0); PG8_STAGE(PG8_SA(0, 1), a2 + hstep, voffA);
            PG8_WAIT_L(8); PG8_BAR; PG8_WAIT_L(0); PG8_MMA(0, 0, At, B0); PG8_BAR; PG8_SCHED;
            PG8_LDB(B1, 1, 1); PG8_STAGE(PG8_SB(1, 0), b3, voffB);
            PG8_BAR; PG8_WAIT_L(0); PG8_MMA(0, 1, At, B1); PG8_BAR;
            PG8_LDA(At, 1, 1); PG8_STAGE(PG8_SA(1, 0), a3, voffA);
            PG8_BAR; PG8_WAIT_L(0); PG8_MMA(1, 0, At, B0); PG8_BAR; PG8_SCHED;
            PG8_STAGE(PG8_SB(1, 1), b3 + hstep, voffB);
            PG8_WAIT_V(6); PG8_BAR; PG8_MMA(1, 1, At, B1); PG8_BAR;
            }
        }
        if constexpr (ALIGN_EPI) { if (wr == 0) PG8_BAR; }
        if constexpr (!Epi::AFTER_DRAIN) { E(acc, cur, wr, wc, fr, fq); S.done(cur); }
        if (!has_next) break;
#pragma unroll
        for (int a = 0; a < 2; ++a)
#pragma unroll
            for (int b = 0; b < 2; ++b)
#pragma unroll
                for (int m = 0; m < 4; ++m)
#pragma unroll
                    for (int n = 0; n < 2; ++n) acc[a][b][m][n] = (f32x4){0.f, 0.f, 0.f, 0.f};
        cur = nxt; cA = nA; cB = nB; ++ui;
        if constexpr (GATHER) {
#pragma unroll
            for (int h_ = 0; h_ < 2; ++h_)
#pragma unroll
                for (int i_ = 0; i_ < 2; ++i_) offC[h_][i_] = offN[h_][i_]; }
        if constexpr (ALIGN_EPI) { if (wr == 1) PG8_BAR; }
    }
    PG8_WAIT_V(0);
    if constexpr (!ALIGN_EPI) { if (wr == 0) PG8_BAR; }
    PG8_BAR;
    if constexpr (Epi::AFTER_DRAIN) { E.fused(acc, cur, wr, wc, fr, fq, lds, wid, lane); S.done(cur); }
#undef PG8_SA
#undef PG8_GOFF
#undef PG8_STA
#undef PG8_SB
#undef PG8_STAGE
#undef PG8_LDA
#undef PG8_LDB
#undef PG8_MMA
#undef PG8_WAIT_V
#undef PG8_WAIT_L
#undef PG8_BAR
#undef PG8_SCHED
}
}
#define XB_TMO      128
#define XB_XCNT(j)  (256  + 64 * (j))
#define XB_XSUB(j)  (1280 + 64 * (j))
#define XB_XGEN(j)  (2304 + 64 * (j))
#define XB_TOP      3328
#define XB_TOPGEN   3392
#define XCD_BAR_WORDS 3456
#define XB_SPIN_CAP (1u << 18)

__device__ __forceinline__ unsigned xb_ld(unsigned* p)              { return __hip_atomic_load(p, __ATOMIC_RELAXED, __HIP_MEMORY_SCOPE_AGENT); }
__device__ __forceinline__ unsigned xb_add(unsigned* p, unsigned v) { return __hip_atomic_fetch_add(p, v, __ATOMIC_RELAXED, __HIP_MEMORY_SCOPE_AGENT); }
__device__ __forceinline__ unsigned xb_xcc_id() { return (unsigned)__builtin_amdgcn_s_getreg((3 << 11) | 20) & 0xFu; }
#define XB_SPIN(cond, bar) do { unsigned _sp = 0; while (cond) { __builtin_amdgcn_s_sleep(1); \
    if ((++_sp & 255u) == 0u) { if (xb_ld(&(bar)[XB_TMO])) break; if (_sp > XB_SPIN_CAP) { atomicAdd(&(bar)[XB_TMO], 1u); break; } } } } while (0)

struct XcdBarrier {
    unsigned* bar; unsigned x;
    volatile LAS unsigned* st;
};

__device__ __forceinline__ XcdBarrier xcd_barrier_post(unsigned* bar, volatile LAS unsigned* st) {
    XcdBarrier b; b.bar = bar; b.x = xb_xcc_id(); b.st = st;
    if (threadIdx.x == 0) (void)xb_add(&bar[XB_XCNT(b.x)], 1u);
    return b;
}
__device__ __forceinline__ void xcd_barrier_complete(unsigned* bar, unsigned x, unsigned& nloc, unsigned& nx) {
    const unsigned G = gridDim.x * gridDim.y * gridDim.z;
    unsigned sum, cnt, mine, sp = 0u;
    for (;;) {
        sum = 0u; cnt = 0u; mine = 0u;
#pragma unroll
        for (unsigned j = 0; j < 16; ++j) { const unsigned c = xb_ld(&bar[XB_XCNT(j)]); sum += c; cnt += (c > 0u) ? 1u : 0u; mine = (j == x) ? c : mine; }
        if (sum == G) break;
        __builtin_amdgcn_s_sleep(1);
        if ((++sp & 255u) == 0u) { if (xb_ld(&bar[XB_TMO])) break; if (sp > XB_SPIN_CAP) { atomicAdd(&bar[XB_TMO], 1u); break; } }
    }
    nloc = mine > 0u ? mine : 1u; nx = cnt > 0u ? cnt : 1u;
}

__device__ __forceinline__ void xcd_barrier(const XcdBarrier& b) {
    asm volatile("s_waitcnt vmcnt(0)" ::: "memory");
    __syncthreads();
    if (threadIdx.x == 0) {
        unsigned* bar = b.bar;
        __builtin_amdgcn_s_waitcnt(0);
        unsigned nloc = b.st[0], nx = b.st[1];
        if (nloc == 0u) { xcd_barrier_complete(bar, b.x, nloc, nx); b.st[0] = nloc; b.st[1] = nx; }
        const unsigned old = xb_add(&bar[XB_XSUB(b.x)], 1u);
        const unsigned gen = old / nloc;
        if (old + 1u == (gen + 1u) * nloc) {
            __builtin_amdgcn_fence(__ATOMIC_RELEASE, "agent");
            asm volatile("s_waitcnt vmcnt(0)" ::: "memory");
            const unsigned og = xb_add(&bar[XB_TOP], 1u);
            const unsigned tg = og / nx;
            if (og + 1u == (tg + 1u) * nx) xb_add(&bar[XB_TOPGEN], 1u);
            else XB_SPIN(xb_ld(&bar[XB_TOPGEN]) == tg, bar);
            __builtin_amdgcn_fence(__ATOMIC_ACQUIRE, "agent");
            xb_add(&bar[XB_XGEN(b.x)], 1u);
            asm volatile("s_waitcnt vmcnt(0)" ::: "memory");
        } else {
            XB_SPIN(xb_ld(&bar[XB_XGEN(b.x)]) == gen, bar);
            __builtin_amdgcn_fence(__ATOMIC_ACQUIRE, "agent");
            asm volatile("s_waitcnt vmcnt(0)" ::: "memory");
        }
    }
    __syncthreads();
}
namespace pg8 {
struct EpiIn0 {
    static constexpr bool PERM = true, AFTER_DRAIN = false;
    bf16_t *Q, *K, *V, *Z, *XBC; float* DT; float qscale;
    __device__ __forceinline__ void operator()(const f32x4 (&acc)[2][2][4][2], const Unit& u, int wr, int wc, int fr, int fq) const {
        const int pn = u.pn, row0 = u.pm * BM + wr * 64 + fr;
        if (pn == 22) {
            if (wc == 0 && fq < 2) {
#pragma unroll
                for (int ai = 0; ai < 2; ++ai)
#pragma unroll
                    for (int m = 0; m < 4; ++m) { float* p = DT + (size_t)(row0 + ai * HALF + m * 16) * 16 + 8 * fq; *(f32x4*)p = acc[ai][0][m][0]; *(f32x4*)(p + 4) = acc[ai][0][m][1]; }
            }
            return;
        }
        bf16_t* base; int ld = 1024, colt; float sc = 1.f;
        if (pn < 4) { base = Q; colt = pn * BM; sc = qscale; } else if (pn < 8) { base = K; colt = (pn - 4) * BM; } else if (pn < 12) { base = V; colt = (pn - 8) * BM; }
        else if (pn < 16) { base = Z; colt = (pn - 12) * BM; } else { base = XBC; ld = 1536; colt = (pn - 16) * BM; }
        const int col0 = colt + wc * 32 + 8 * fq;
#pragma unroll
        for (int ai = 0; ai < 2; ++ai)
#pragma unroll
            for (int m = 0; m < 4; ++m) { bf16_t* rowp = base + (size_t)(row0 + ai * HALF + m * 16) * ld + col0;
#pragma unroll
                for (int bj = 0; bj < 2; ++bj) { const f32x4 v0 = acc[ai][bj][m][0] * sc, v1 = acc[ai][bj][m][1] * sc;
                    u32x4 w; w.x = cvt_pk_bf16(v0[0], v0[1]); w.y = cvt_pk_bf16(v0[2], v0[3]); w.z = cvt_pk_bf16(v1[0], v1[1]); w.w = cvt_pk_bf16(v1[2], v1[3]);
                    *(u32x4*)(rowp + bj * HALF) = w; } }
    }
};
struct EpiIn1 {
    static constexpr bool PERM = true, AFTER_DRAIN = false;
    bf16_t *Q, *KC, *VC, *KS, *VST, *KW, *VWT; float qscale;
    __device__ __forceinline__ void operator()(const f32x4 (&acc)[2][2][4][2], const Unit& u, int wr, int wc, int fr, int fq) const {
        const int pn = u.pn, row0 = u.pm * BM + wr * 64 + fr;
        if (pn < 8) {
            const int col0 = pn * BM + wc * 32 + 8 * fq;
#pragma unroll
            for (int ai = 0; ai < 2; ++ai)
#pragma unroll
                for (int m = 0; m < 4; ++m) { bf16_t* rowp = Q + (size_t)(row0 + ai * HALF + m * 16) * 2048 + col0;
#pragma unroll
                    for (int bj = 0; bj < 2; ++bj) { const f32x4 v0 = acc[ai][bj][m][0] * qscale, v1 = acc[ai][bj][m][1] * qscale;
                        u32x4 w; w.x = cvt_pk_bf16(v0[0], v0[1]); w.y = cvt_pk_bf16(v0[2], v0[3]); w.z = cvt_pk_bf16(v1[0], v1[1]); w.w = cvt_pk_bf16(v1[2], v1[3]);
                        *(u32x4*)(rowp + bj * HALF) = w; } }
            return;
        }
        const int idx = (pn - 8) >> 1, gp = (pn - 8) & 1, d0 = wc * 32 + 8 * fq;
        bf16_t* base = idx == 0 ? KC : idx == 1 ? VC : idx == 2 ? KS : idx == 3 ? VST : idx == 4 ? KW : VWT;
        const bool tr = (idx == 3 || idx == 5);
#pragma unroll
        for (int ai = 0; ai < 2; ++ai)
#pragma unroll
            for (int m = 0; m < 4; ++m) { const int row = row0 + ai * HALF + m * 16, b = row >> 13, s = row & 8191;
#pragma unroll
                for (int bj = 0; bj < 2; ++bj) { const int g = 2 * gp + bj; const f32x4 v0 = acc[ai][bj][m][0], v1 = acc[ai][bj][m][1];
                    if (!tr) { u32x4 w; w.x = cvt_pk_bf16(v0[0], v0[1]); w.y = cvt_pk_bf16(v0[2], v0[3]); w.z = cvt_pk_bf16(v1[0], v1[1]); w.w = cvt_pk_bf16(v1[2], v1[3]);
                        *(u32x4*)(base + ((size_t)(b * 4 + g) * 8192 + s) * 128 + d0) = w; }
                    else { bf16_t* p = base + ((size_t)(b * 4 + g) * 128 + d0) * 8192 + s;
                        p[0 * 8192] = (bf16_t)f2bf(v0[0]); p[1 * 8192] = (bf16_t)f2bf(v0[1]); p[2 * 8192] = (bf16_t)f2bf(v0[2]); p[3 * 8192] = (bf16_t)f2bf(v0[3]);
                        p[4 * 8192] = (bf16_t)f2bf(v1[0]); p[5 * 8192] = (bf16_t)f2bf(v1[1]); p[6 * 8192] = (bf16_t)f2bf(v1[2]); p[7 * 8192] = (bf16_t)f2bf(v1[3]); } } }
    }
};
struct EpiOut {
    static constexpr bool PERM = false, AFTER_DRAIN = false;
    const float* X; bf16_t* Y; float alpha;
    __device__ __forceinline__ void operator()(const f32x4 (&acc)[2][2][4][2], const Unit& u, int wr, int wc, int fr, int fq) const {
        const int row0 = u.pm * BM + wr * 64 + fr, col0 = u.pn * BM + wc * 32 + 4 * fq;
#pragma unroll
        for (int ai = 0; ai < 2; ++ai) { f32x4 xv[4][2][2];
#pragma unroll
            for (int m = 0; m < 4; ++m)
#pragma unroll
                for (int bj = 0; bj < 2; ++bj)
#pragma unroll
                    for (int n = 0; n < 2; ++n) xv[m][bj][n] = *(const f32x4*)(X + (size_t)(row0 + ai * HALF + m * 16) * 2048 + col0 + bj * HALF + n * 16);
#pragma unroll
            for (int m = 0; m < 4; ++m)
#pragma unroll
                for (int bj = 0; bj < 2; ++bj)
#pragma unroll
                    for (int n = 0; n < 2; ++n) { const f32x4 yv = xv[m][bj][n] * alpha + acc[ai][bj][m][n]; u32x2 w; w.x = cvt_pk_bf16(yv[0], yv[1]); w.y = cvt_pk_bf16(yv[2], yv[3]);
                        *(u32x2*)(Y + (size_t)(row0 + ai * HALF + m * 16) * 2048 + col0 + bj * HALF + n * 16) = w; } }
    }
};
struct EpiOutB {
    static constexpr bool PERM = false, AFTER_DRAIN = false;
    const bf16_t* X; bf16_t* Y; float alpha;
    __device__ __forceinline__ void operator()(const f32x4 (&acc)[2][2][4][2], const Unit& u, int wr, int wc, int fr, int fq) const {
        const int row0 = u.pm * BM + wr * 64 + fr, col0 = u.pn * BM + wc * 32 + 4 * fq;
#pragma unroll
        for (int ai = 0; ai < 2; ++ai) { u32x2 xv[4][2][2];
#pragma unroll
            for (int m = 0; m < 4; ++m)
#pragma unroll
                for (int bj = 0; bj < 2; ++bj)
#pragma unroll
                    for (int n = 0; n < 2; ++n) xv[m][bj][n] = *(const u32x2*)(X + (size_t)(row0 + ai * HALF + m * 16) * 2048 + col0 + bj * HALF + n * 16);
#pragma unroll
            for (int m = 0; m < 4; ++m)
#pragma unroll
                for (int bj = 0; bj < 2; ++bj)
#pragma unroll
                    for (int n = 0; n < 2; ++n) { const u32x2 x = xv[m][bj][n]; f32x4 xf; xf[0] = __uint_as_float(x.x << 16); xf[1] = __uint_as_float(x.x & 0xffff0000u); xf[2] = __uint_as_float(x.y << 16); xf[3] = __uint_as_float(x.y & 0xffff0000u);
                        const f32x4 yv = xf * alpha + acc[ai][bj][m][n]; u32x2 w; w.x = cvt_pk_bf16(yv[0], yv[1]); w.y = cvt_pk_bf16(yv[2], yv[3]);
                        *(u32x2*)(Y + (size_t)(row0 + ai * HALF + m * 16) * 2048 + col0 + bj * HALF + n * 16) = w; } }
    }
};
struct MoeOrder {
    const PG8_LAS int* tab; int G, c;
    __device__ __forceinline__ bool next(int i, Unit& u) const {
        const int n_mt = tab[0], x = c & 7, j = c >> 3, gidx = i * 8 + x, mt = gidx * 4 + (j >> 3), nt = j & 7;
        if (j >= 32 || mt >= n_mt) return false;
        u.pm = mt; u.pn = tab[64 + mt] * 8 + nt; return true;
    }
    __device__ __forceinline__ void a_ready(const Unit&) const {}
    __device__ __forceinline__ void done(const Unit&) const {}
};
struct EpiMoe1 {
    static constexpr bool PERM = true, AFTER_DRAIN = false;
    bf16_t* HID;
    __device__ __forceinline__ void operator()(const f32x4 (&acc)[2][2][4][2], const Unit& u, int wr, int wc, int fr, int fq) const {
        const int row0 = u.pm * BM + wr * 64 + fr, col0 = (u.pn & 7) * 128 + wc * 32 + 8 * fq;
#pragma unroll
        for (int ai = 0; ai < 2; ++ai)
#pragma unroll
            for (int m = 0; m < 4; ++m) { float h[8];
#pragma unroll
                for (int n = 0; n < 2; ++n)
#pragma unroll
                    for (int i = 0; i < 4; ++i) { const float g = acc[ai][0][m][n][i], up = acc[ai][1][m][n][i]; h[n * 4 + i] = g * __builtin_amdgcn_rcpf(1.f + __expf(-g)) * up; }
                u32x4 w; w.x = cvt_pk_bf16(h[0], h[1]); w.y = cvt_pk_bf16(h[2], h[3]); w.z = cvt_pk_bf16(h[4], h[5]); w.w = cvt_pk_bf16(h[6], h[7]);
                *(u32x4*)(HID + (size_t)(row0 + ai * HALF + m * 16) * 1024 + col0) = w; }
    }
};
struct EpiMoe2 {
    static constexpr bool PERM = true, AFTER_DRAIN = false;
    bf16_t* FOUT; const PG8_LAS int* rt; const PG8_LAS float* rw;
    __device__ __forceinline__ void operator()(const f32x4 (&acc)[2][2][4][2], const Unit& u, int wr, int wc, int fr, int fq) const {
        const int lr0 = (u.pm >> 5) * 256 + wr * 64 + fr, col0 = (u.pn & 7) * BM + wc * 32 + 8 * fq;
        int slots[2][4]; float gws[2][4];
#pragma unroll
        for (int ai = 0; ai < 2; ++ai)
#pragma unroll
            for (int m = 0; m < 4; ++m) { const int lr = lr0 + ai * HALF + m * 16; slots[ai][m] = rt[lr]; gws[ai][m] = rw[lr]; }
#pragma unroll
        for (int ai = 0; ai < 2; ++ai)
#pragma unroll
            for (int m = 0; m < 4; ++m) { const int slot = slots[ai][m]; const float gw = gws[ai][m];
                if (slot >= 0) { bf16_t* rowp = FOUT + (size_t)slot * 2048 + col0;
#pragma unroll
                    for (int bj = 0; bj < 2; ++bj) { const f32x4 v0 = acc[ai][bj][m][0] * gw, v1 = acc[ai][bj][m][1] * gw;
                        u32x4 w; w.x = cvt_pk_bf16(v0[0], v0[1]); w.y = cvt_pk_bf16(v0[2], v0[3]); w.z = cvt_pk_bf16(v1[0], v1[1]); w.w = cvt_pk_bf16(v1[2], v1[3]);
                        *(u32x4*)(rowp + bj * HALF) = w; } } }
    }
};
}

template <int NC, int KU, class AF, class BF>
__device__ __forceinline__ f32x16 small_gemm(LAS unsigned char* lds, int K, const AF& af, const BF& bfn, int tid) {
    constexpr int KS = 4 / NC, BKS = 64 * KS * KU, PITCH = BKS + 8, CPR = BKS / 8;
    constexpr int NA = 64 * CPR / NTHR, NB = 32 * NC * CPR / NTHR;
    static_assert(NA >= 1 && NB >= 1, "small_gemm geometry");
    LAS bf16* As = (LAS bf16*)lds;
    const int lane = tid & 63, wave = tid >> 6, wr = wave & 1, j = wave >> 1, wc = j % NC, kq = j / NC;
    typename AF::Raw ra0[NA], ra1[NA]; bf16x8 rb0[NB], rb1[NB];
    f32x16 acc;
#pragma unroll
    for (int i = 0; i < 16; ++i) acc[i] = 0.f;
    const int ns = K / BKS;
#define SG_LOAD(RA, RB, step) do { const int st_ = (step); \
        _Pragma("unroll") for (int i = 0; i < NA; ++i) { const int c = tid + NTHR * i; RA[i] = af.raw(c / CPR, st_ * CPR + c % CPR); } \
        _Pragma("unroll") for (int i = 0; i < NB; ++i) { const int c = tid + NTHR * i; RB[i] = bfn(c / CPR, st_ * CPR + c % CPR); } } while (0)
    constexpr int BUFE = (64 + 32 * NC) * PITCH;
#define SG_WRITE(RA, RB, cstep, b_) do { LAS bf16* Aw_ = As + (b_) * BUFE; LAS bf16* Bw_ = Aw_ + 64 * PITCH; const int cs_ = (cstep); \
        _Pragma("unroll") for (int i = 0; i < NA; ++i) { const int c = tid + NTHR * i; *(LAS bf16x8*)(Aw_ + (c / CPR) * PITCH + (c % CPR) * 8) = af.fin(RA[i], cs_ * CPR + c % CPR); } \
        _Pragma("unroll") for (int i = 0; i < NB; ++i) { const int c = tid + NTHR * i; *(LAS bf16x8*)(Bw_ + (c / CPR) * PITCH + (c % CPR) * 8) = RB[i]; } } while (0)
#define SG_MMA(b_) do { const LAS bf16* ap = As + (b_) * BUFE + (wr * 32 + (lane & 31)) * PITCH + kq * 64 * KU + 8 * (lane >> 5); \
          const LAS bf16* bp = As + (b_) * BUFE + 64 * PITCH + (wc * 32 + (lane & 31)) * PITCH + kq * 64 * KU + 8 * (lane >> 5); \
          _Pragma("unroll") for (int k0 = 0; k0 < 64 * KU; k0 += 64) {        \
            bf16x8 fa_[4], fb_[4]; \
            _Pragma("unroll") for (int k = 0; k < 4; ++k) { fa_[k] = *(const LAS bf16x8*)(ap + k0 + 16 * k); fb_[k] = *(const LAS bf16x8*)(bp + k0 + 16 * k); } \
            __builtin_amdgcn_sched_barrier(0); \
            _Pragma("unroll") for (int k = 0; k < 4; ++k) acc = __builtin_amdgcn_mfma_f32_32x32x16_bf16(fa_[k], fb_[k], acc, 0, 0, 0); } } while (0)
    SG_LOAD(ra0, rb0, 0); __builtin_amdgcn_sched_barrier(0); SG_LOAD(ra1, rb1, 1); __builtin_amdgcn_sched_barrier(0);
    SG_WRITE(ra0, rb0, 0, 0); SG_LOAD(ra0, rb0, min(2, ns - 1)); __builtin_amdgcn_sched_barrier(0);
    for (int s = 0; s < ns; s += 2) {
        __syncthreads(); SG_WRITE(ra1, rb1, min(s + 1, ns - 1), 1); SG_LOAD(ra1, rb1, min(s + 3, ns - 1)); SG_MMA(0);
        __syncthreads(); SG_WRITE(ra0, rb0, min(s + 2, ns - 1), 0); SG_LOAD(ra0, rb0, min(s + 4, ns - 1)); SG_MMA(1);
    }
    __syncthreads();
#undef SG_LOAD
#undef SG_WRITE
#undef SG_MMA
    return acc;
}
struct Args { const float* in[31]; float* out; unsigned char* wsbase; int ph_lo, ph_hi; };
struct Frame {
    LAS unsigned char* lds;
    volatile LAS unsigned* MISC;
    gu32* ctl;
    int tid, lane, wave, G, vcu;
    unsigned char* ws_;
};

__device__ __forceinline__ bool frame_refresh(Frame& F, unsigned char* ws_) { { const unsigned long long u_ = (unsigned long long)ws_; ws_ = (unsigned char*)((unsigned long long)(unsigned)__builtin_amdgcn_readfirstlane((unsigned)u_) | ((unsigned long long)(unsigned)__builtin_amdgcn_readfirstlane((unsigned)(u_ >> 32)) << 32)); }
    GAS unsigned char* wg_ = (GAS unsigned char*)ws_; asm volatile("" : "+s"(wg_)); ws_ = (unsigned char*)wg_; F.ws_ = ws_; F.ctl = (gu32*)(ws_ + WS_CTL); int t = threadIdx.x; asm volatile("" : "+v"(t)); F.tid = t; F.lane = t & 63; F.wave = __builtin_amdgcn_readfirstlane(t >> 6); return true; }

struct TrJob { const float* W; int ldw, src_col0, nvalid, nblk; bf16* WT; int ldt, koff, mode; };
typedef float f32x2_t __attribute__((ext_vector_type(2))); typedef __bf16 bf16x2_t __attribute__((ext_vector_type(2)));
__device__ __forceinline__ unsigned cvtpk(float lo, float hi) { const f32x2_t v = {lo, hi}; const bf16x2_t b = __builtin_convertvector(v, bf16x2_t); return __builtin_bit_cast(unsigned, b); }
constexpr int TR_SMALL_ITEMS = 32 * 92 + 32 * 32 + 32 * 80 + 32 * 2 + 32 * 32 + 3 * 32 + 64 * 2 + 64 * 2 + 4 + 4;
constexpr int TR_MOE_ITEMS = 2 * 32 * 1536;
__device__ __forceinline__ void tr_job(const Args& a, unsigned char* ws, int it, TrJob& J, int& item) {
    int r = it;
    J.src_col0 = 0; J.koff = 0; J.mode = 0;
    if (r >= TR_SMALL_ITEMS) {
        r -= TR_SMALL_ITEMS; const int le = r / 1536, w = r % 1536, which = w >> 9, l = le >> 5, e = le & 31; item = w & 511;
        if (which < 2) { J.W = (which == 0 ? a.in[28] : a.in[29]) + (size_t)le * 2048 * 1024; J.ldw = 1024; J.nvalid = 1024; J.nblk = 16;
            J.WT = (bf16*)(ws + WS_MOEB1 + (size_t)l * 256 * MiB) + (size_t)e * 2048 * 2048; J.ldt = 2048; J.mode = 1 + which; }
        else { J.W = a.in[30] + (size_t)le * 1024 * 2048; J.ldw = 2048; J.nvalid = 2048; J.nblk = 32;
            J.WT = (bf16*)(ws + WS_MOEB2 + (size_t)l * 128 * MiB) + (size_t)e * 2048 * 1024; J.ldt = 1024; }
        return;
    }
    if (r < 32 * 92) { J.W = a.in[3]; J.ldw = EVEN_IN; J.nvalid = EVEN_IN; J.nblk = 92; J.WT = (bf16*)(ws + WS_WIN0T); J.ldt = 2048; item = r; return; } r -= 32 * 92;
    if (r < 32 * 32) { J.W = a.in[4]; J.ldw = 2048; J.nvalid = 2048; J.nblk = 32; J.WT = (bf16*)(ws + WS_WOUT0T); J.ldt = 2048; item = r; return; } r -= 32 * 32;
    if (r < 32 * 80) { J.W = a.in[16]; J.ldw = ODD_IN; J.nvalid = ODD_MAIN; J.nblk = 80; J.WT = (bf16*)(ws + WS_WIN1T); J.ldt = 2048; item = r; return; } r -= 32 * 80;
    if (r < 32 * 2) { J.W = a.in[16]; J.ldw = ODD_IN; J.src_col0 = ODD_MAIN; J.nvalid = 48; J.nblk = 2; J.WT = (bf16*)(ws + WS_WGT); J.ldt = 2048; item = r; return; } r -= 32 * 2;
    if (r < 32 * 32) { J.W = a.in[17]; J.ldw = 2048; J.nvalid = 2048; J.nblk = 32; J.WT = (bf16*)(ws + WS_WOUT1T); J.ldt = 2048; item = r; return; } r -= 32 * 32;
    if (r < 96) { const int seg = r >> 5; J.W = a.in[1]; J.ldw = 32; J.nvalid = 32; J.nblk = 1; J.WT = (bf16*)(ws + WS_WRT3); J.ldt = 6144; J.koff = seg * 2048; J.mode = (seg == 1) ? 3 : 0; item = r & 31; return; } r -= 96;
    if (r < 128) { J.W = a.in[20]; J.ldw = 128; J.nvalid = 128; J.nblk = 2; J.WT = (bf16*)(ws + WS_W1KT); J.ldt = 4096; item = r; return; } r -= 128;
    if (r < 128) { J.W = a.in[22]; J.ldw = 128; J.nvalid = 128; J.nblk = 2; J.WT = (bf16*)(ws + WS_W1VT); J.ldt = 4096; item = r; return; } r -= 128;
    if (r < 4) { J.W = a.in[21]; J.ldw = 128; J.nvalid = 128; J.nblk = 2; J.WT = (bf16*)(ws + WS_W2KT); J.ldt = 128; item = r; return; } r -= 4;
    { J.W = a.in[23]; J.ldw = 128; J.nvalid = 128; J.nblk = 2; J.WT = (bf16*)(ws + WS_W2VT); J.ldt = 128; item = r; }
}
__device__ __forceinline__ void tr_load(const TrJob& J, int item, int lane, f32x4 (&v)[16]) {
    const int kb = item / J.nblk, nb = item % J.nblk, k0 = 64 * kb, n0 = 64 * nb, kp = lane >> 4, nc = lane & 15;
    const bool ok = (n0 + 4 * nc) < J.nvalid;
    const float* src = J.W + (size_t)(k0 + 2 * kp) * J.ldw + J.src_col0 + n0 + 4 * nc;
#pragma unroll
    for (int i = 0; i < 8; ++i) { v[2 * i] = ok ? *(const f32x4*)(src + (size_t)(8 * i) * J.ldw) : (f32x4){0.f, 0.f, 0.f, 0.f}; v[2 * i + 1] = ok ? *(const f32x4*)(src + (size_t)(8 * i + 1) * J.ldw) : (f32x4){0.f, 0.f, 0.f, 0.f}; }
}
__device__ __forceinline__ void tr_store(const TrJob& J, int item, int lane, const f32x4 (&v)[16], LAS unsigned* T) {
    const int kb = item / J.nblk, nb = item % J.nblk, k0 = 64 * kb, n0 = 64 * nb, kp = lane >> 4, nc = lane & 15;
#pragma unroll
    for (int i = 0; i < 8; ++i)
#pragma unroll
        for (int j = 0; j < 4; ++j) { float a = v[2 * i][j], b = v[2 * i + 1][j];
            if (J.mode == 3) { a = a - bf2f(f2bf(a)); b = b - bf2f(f2bf(b)); }
            T[(4 * nc + j) * 36 + 4 * i + kp] = cvtpk(a, b); }
    LDS_WAIT(); asm volatile("" ::: "memory");
#pragma unroll
    for (int p = 0; p < 8; ++p) { const int id = lane + 64 * p, n = id >> 3, c = id & 7; const u32x4 o = *(const LAS u32x4*)(T + n * 36 + 4 * c);
        const int nn = n0 + n; int row = nn;
        if (J.mode == 1) row = (nn >> 7) * 256 + (nn & 127); else if (J.mode == 2) row = (nn >> 7) * 256 + 128 + (nn & 127);
        *(u32x4*)(J.WT + (size_t)row * J.ldt + J.koff + k0 + 8 * c) = o; }
    LDS_WAIT(); asm volatile("" ::: "memory");
}
__device__ __forceinline__ void tr_run(Frame& F, const Args& a, const int it_begin, const int it_end) {
    const int lane = F.lane, wave = F.wave;
    LAS unsigned* T = (LAS unsigned*)(F.lds + wave * 16384);
    const int gw = F.vcu * NWAVES + wave, NGW = F.G * NWAVES;
    f32x4 cur[16], n1[16], n2[16]; TrJob Jc, J1, J2; int ic = 0, i1 = 0, i2 = 0;
    int it = it_begin + gw;
    if (it < it_end) { tr_job(a, F.ws_, it, Jc, ic); tr_load(Jc, ic, lane, cur); }
    if (it + NGW < it_end) { tr_job(a, F.ws_, it + NGW, J1, i1); tr_load(J1, i1, lane, n1); }
    while (it < it_end) {
        const int it2 = it + 2 * NGW;
        if (it2 < it_end) { tr_job(a, F.ws_, it2, J2, i2); tr_load(J2, i2, lane, n2); }
        tr_store(Jc, ic, lane, cur, T);
#pragma unroll
        for (int i = 0; i < 16; ++i) { cur[i] = n1[i]; n1[i] = n2[i]; }
        Jc = J1; ic = i1; J1 = J2; i1 = i2;
        it += NGW;
    }
}
constexpr int TR_MOE_LAYER_ITEMS = 32 * 1536;
__device__ __forceinline__ void tr_moe_slice(Frame& F, const Args& a, int l, int s, int ns) {
    const int per = TR_MOE_LAYER_ITEMS / ns, base = TR_SMALL_ITEMS + l * TR_MOE_LAYER_ITEMS + s * per;
    tr_run(F, a, base, base + per);
}
struct MoeItem { const char* sb; char* db; int down; };
__device__ __forceinline__ MoeItem moe_item2(const Args& a, unsigned char* ws, int layer, int sidx, int it);
__device__ __forceinline__ MoeItem moe_item(const Args& a, unsigned char* ws, int layer, int q, int gw) { return moe_item2(a, ws, layer, gw + 2048 * (q >> 2), q & 3); }
__device__ __forceinline__ MoeItem moe_item2(const Args& a, unsigned char* ws, int layer, int sidx, int it) {
    const int e = sidx / 384, r = sidx % 384, le = layer * 32 + e; MoeItem M;
    if (r < 256) { const int which = r >> 7, rr = r & 127, kb = rr >> 2, nq = rr & 3;
        const float* W = (which ? a.in[29] : a.in[28]) + (size_t)le * 2048 * 1024;
        M.sb = (const char*)(W + (size_t)(64 * kb) * 1024 + nq * 256 + it * 64);
        bf16* D = (bf16*)(ws + WS_MOEB1 + (size_t)layer * 256 * MiB) + (size_t)e * 2048 * 2048;
        M.db = (char*)(D + (size_t)((nq * 2 + (it >> 1)) * 256 + which * 128 + 64 * (it & 1)) * 2048 + 64 * kb); M.down = 0; }
    else { const int rr = r - 256, kb = rr >> 3, nq = rr & 7;
        const float* W = a.in[30] + (size_t)le * 1024 * 2048;
        M.sb = (const char*)(W + (size_t)(64 * kb) * 2048 + nq * 256 + it * 64);
        bf16* D = (bf16*)(ws + WS_MOEB2 + (size_t)layer * 128 * MiB) + (size_t)e * 2048 * 1024;
        M.db = (char*)(D + (size_t)(nq * 256 + it * 64) * 1024 + 64 * kb); M.down = 1; }
    return M;
}
template <int LDW> __device__ __forceinline__ void moe_ld(const char* sb, unsigned loff, f32x4 (&v)[16]) {
#pragma unroll
    for (int i = 0; i < 8; ++i) { v[2 * i] = __builtin_nontemporal_load((const f32x4*)(sb + (size_t)(8 * i) * LDW * 4 + loff)); v[2 * i + 1] = __builtin_nontemporal_load((const f32x4*)(sb + (size_t)(8 * i + 1) * LDW * 4 + loff)); }
}
template <int LDT> __device__ __forceinline__ void moe_st(const f32x4 (&v)[16], LAS unsigned* T, unsigned tw, unsigned trd, char* db, unsigned doff) {
#pragma unroll
    for (int i = 0; i < 8; ++i)
#pragma unroll
        for (int j = 0; j < 4; ++j) T[tw + j * 36 + 4 * i] = cvtpk(v[2 * i][j], v[2 * i + 1][j]);
    LDS_WAIT(); asm volatile("" ::: "memory");
#pragma unroll
    for (int p = 0; p < 8; ++p) { const u32x4 o = *(const LAS u32x4*)(T + trd + p * 8 * 36); __builtin_nontemporal_store(o, (u32x4*)(db + (size_t)p * 8 * LDT * 2 + doff)); }
    LDS_WAIT(); asm volatile("" ::: "memory");
}
__device__ __forceinline__ void tr_moe_layer(Frame& F, const Args& a, int layer) {
    int tid = threadIdx.x; asm volatile("" : "+v"(tid)); const int lane = tid & 63, wave = __builtin_amdgcn_readfirstlane(tid >> 6);
    LAS unsigned* T = (LAS unsigned*)(F.lds + wave * 16384);
    const int gw = F.vcu * NWAVES + wave, kp = lane >> 4, nc = lane & 15;
    const unsigned loffA = (unsigned)((2 * kp) * 1024 + 4 * nc) * 4u, loffB = (unsigned)((2 * kp) * 2048 + 4 * nc) * 4u;
    const unsigned doffA = (unsigned)((lane >> 3) * 2048 + 8 * (lane & 7)) * 2u, doffB = (unsigned)((lane >> 3) * 1024 + 8 * (lane & 7)) * 2u;
    const unsigned tw = (unsigned)(4 * nc) * 36u + (unsigned)kp, trd = (unsigned)(lane >> 3) * 36u + 4u * (unsigned)(lane & 7);
    const int sbase = F.vcu * 48 + (wave >> 2), itw = wave & 3;
    f32x4 cur[16], n1[16], n2[16]; MoeItem Mc, M1, M2;
    Mc = moe_item2(a, F.ws_, layer, sbase, itw); if (Mc.down) moe_ld<2048>(Mc.sb, loffB, cur); else moe_ld<1024>(Mc.sb, loffA, cur);
    M1 = moe_item2(a, F.ws_, layer, sbase + 2, itw); if (M1.down) moe_ld<2048>(M1.sb, loffB, n1); else moe_ld<1024>(M1.sb, loffA, n1);
    for (int q = 0; q < 24; ++q) {
        if (q + 2 < 24) { M2 = moe_item2(a, F.ws_, layer, sbase + 2 * (q + 2), itw); if (M2.down) moe_ld<2048>(M2.sb, loffB, n2); else moe_ld<1024>(M2.sb, loffA, n2); }
        if (Mc.down) moe_st<1024>(cur, T, tw, trd, Mc.db, doffB); else moe_st<2048>(cur, T, tw, trd, Mc.db, doffA);
#pragma unroll
        for (int i = 0; i < 16; ++i) { cur[i] = n1[i]; n1[i] = n2[i]; }
        Mc = M1; M1 = M2;
    }
}
__device__ __forceinline__ void phase_prologue(Frame& F, const Args& a) {
    tr_run(F, a, 0, TR_SMALL_ITEMS);
#if !MOE_CVT_IN_ATTN
    tr_run(F, a, TR_SMALL_ITEMS, TR_SMALL_ITEMS + TR_MOE_ITEMS);
#endif
    const f32x4* x4 = (const f32x4*)a.in[0]; u32x2* xb = (u32x2*)(F.ws_ + WS_XB);
    const size_t T_ = (size_t)F.G * NTHR, N4_ = (size_t)NTOK * DM / 4; size_t i = (size_t)blockIdx.x * NTHR + F.tid;
    for (; i + 15 * T_ < N4_; i += 16 * T_) { f32x4 v[16];
#pragma unroll
        for (int k = 0; k < 16; ++k) v[k] = __builtin_nontemporal_load(x4 + i + k * T_);
#pragma unroll
        for (int k = 0; k < 16; ++k) { u32x2 o; o.x = cvtpk(v[k].x, v[k].y); o.y = cvtpk(v[k].z, v[k].w); xb[i + k * T_] = o; } }
    for (; i < N4_; i += T_) { const f32x4 v = x4[i]; u32x2 o; o.x = cvtpk(v.x, v.y); o.y = cvtpk(v.z, v.w); xb[i] = o; }
}

__device__ __forceinline__ void ln_stats(f32x4 (&v)[8], float& mean, float& rstd) {
    float s = 0.f;
#pragma unroll
    for (int j = 0; j < 8; ++j) s += (v[j].x + v[j].y) + (v[j].z + v[j].w);
    mean = wave_sum(s) * (1.f / DM); float s2 = 0.f;
#pragma unroll
    for (int j = 0; j < 8; ++j) { v[j] = v[j] - mean; s2 += (v[j].x * v[j].x + v[j].y * v[j].y) + (v[j].z * v[j].z + v[j].w * v[j].w); }
    rstd = 1.f / sqrtf(wave_sum(s2) * (1.f / DM) + LN_EPS);
}

struct RouterA { const bf16* hb; const bf16* hlo; int r0; typedef bf16x8 Raw;
    __device__ __forceinline__ bf16x8 raw(int r, int kc) const { const int seg = kc >> 8; const bf16* p = hb + (size_t)(r0 + r) * DM + (kc & 255) * 8; (void)seg; return *(const bf16x8*)p; }
    __device__ __forceinline__ bf16x8 fin(bf16x8 x, int) const { return x; } };
struct RouterB { const bf16* w;
    __device__ __forceinline__ bf16x8 operator()(int r, int kc) const { return *(const bf16x8*)(w + (size_t)r * 6144 + kc * 8); } };
__device__ __forceinline__ void phase_ln1_router(Frame& F, const Args& a, int layer) {
    unsigned char* ws = F.ws_; const bf16* RB = (const bf16*)(ws + WS_R); bf16* HB = (bf16*)(ws + WS_HB); bf16* HLO = (bf16*)(ws + WS_HLO);
    const float* g = a.in[24] + layer * DM; const float* bta = a.in[25] + layer * DM; const float* rbias = a.in[2];
    int* tok_e = (int*)(ws + WS_TOK); int* tok_pos = tok_e + 32768; float* tok_w = (float*)(tok_pos + 32768);
    gu32* cnt = F.ctl + CW_CNT + 64 * layer;
    f32x4 gv[8], bv[8];
#pragma unroll
    for (int j = 0; j < 8; ++j) { gv[j] = ((const f32x4*)g)[F.lane + 64 * j]; bv[j] = ((const f32x4*)bta)[F.lane + 64 * j]; }
    for (int u = blockIdx.x; u < NTOK / 64; u += F.G) {
        const int r0 = u * 64;
#define LN1_LOAD(V, i_) do { const u32x2* y_ = (const u32x2*)(RB + (size_t)(r0 + F.wave + 8 * (i_)) * DM) + F.lane; \
            _Pragma("unroll") for (int j = 0; j < 8; ++j) V##r[j] = y_[64 * j]; } while (0)
#define LN1_DO(V, i_) do { const int row = r0 + F.wave + 8 * (i_); f32x4 V[8]; \
            _Pragma("unroll") for (int j = 0; j < 8; ++j) { const u32x2 w_ = V##r[j]; V[j].x = bflo(w_.x); V[j].y = bfhi(w_.x); V[j].z = bflo(w_.y); V[j].w = bfhi(w_.y); } \
            float mean, rstd; ln_stats(V, mean, rstd); \
            u32x2* hb = (u32x2*)(HB + (size_t)row * DM) + F.lane; \
            _Pragma("unroll") for (int j = 0; j < 8; ++j) { const f32x4 h = V[j] * rstd * gv[j] + bv[j]; \
                u32x2 o; o.x = cvtpk(h.x, h.y); o.y = cvtpk(h.z, h.w); hb[64 * j] = o; } } while (0)
        { u32x2 par[8], pbr[8], pcr[8];
          LN1_LOAD(pa, 0); LN1_LOAD(pb, 1); LN1_LOAD(pc, 2); LN1_DO(pa, 0); LN1_LOAD(pa, 3); LN1_DO(pb, 1); LN1_LOAD(pb, 4); LN1_DO(pc, 2); LN1_LOAD(pc, 5);
          LN1_DO(pa, 3); LN1_LOAD(pa, 6); LN1_DO(pb, 4); LN1_LOAD(pb, 7); LN1_DO(pc, 5); LN1_DO(pa, 6); LN1_DO(pb, 7); }
#undef LN1_LOAD
#undef LN1_DO
        VM_WAIT(); __syncthreads();
        RouterA af{HB, HLO, r0}; RouterB bfn{(const bf16*)(ws + WS_WRT3)};
        const f32x16 acc = small_gemm<1, 1>(F.lds, 4096, af, bfn, F.tid);
        LAS float* red = (LAS float*)(F.lds);
        { const int wr = F.wave & 1, kq = F.wave >> 1, hi = F.lane >> 5, col = F.lane & 31;
#pragma unroll
          for (int r = 0; r < 16; ++r) red[(kq * 64 + wr * 32 + crow(r, hi)) * 33 + col] = acc[r]; }
        __syncthreads();
        if (F.tid < 64) {
            const int t = r0 + F.tid; const LAS float* lr = red + F.tid * 33;
            float best = -1e30f; int be1 = 0, be2 = 0; float bw1 = 0.f, bw2 = 0.f;
            for (int gq = 0; gq < 8; ++gq) {
                float t1v = -1e30f, t2v = -1e30f, t1s = 0.f, t2s = 0.f; int t1i = 0, t2i = 0;
#pragma unroll
                for (int i = 0; i < 4; ++i) { const int e = gq * 4 + i; const float lg = lr[e] + lr[64 * 33 + e] + lr[128 * 33 + e] + lr[192 * 33 + e];
                    const float s = 1.f / (1.f + expf(-lg)), bv = s + rbias[e];
                    if (bv > t1v) { t2v = t1v; t2i = t1i; t2s = t1s; t1v = bv; t1i = e; t1s = s; } else if (bv > t2v) { t2v = bv; t2i = e; t2s = s; } }
                const float gs = t1v + t2v;
                if (gs > best) { best = gs; be1 = t1i; be2 = t2i; bw1 = t1s; bw2 = t2s; }
            }
            const float inv = 1.f / (bw1 + bw2);
            const int p1 = (int)__hip_atomic_fetch_add(cnt + be1, 1u, RLX_AGENT), p2 = (int)__hip_atomic_fetch_add(cnt + be2, 1u, RLX_AGENT);
            tok_e[2 * t] = be1; tok_e[2 * t + 1] = be2; tok_pos[2 * t] = p1; tok_pos[2 * t + 1] = p2; tok_w[2 * t] = bw1 * inv; tok_w[2 * t + 1] = bw2 * inv;
        }
        __syncthreads();
    }
}

__device__ __forceinline__ void moe_tables(Frame& F, int layer) {
    LAS int* tab = (LAS int*)(F.lds + MOE_TAB_OFF);
    if (F.tid < 64) {
        const int e = F.lane; int c = 0; if (e < NEXP) c = (int)__hip_atomic_load(F.ctl + CW_CNT + 64 * layer + e, RLX_AGENT);
        const int tiles = (c + 255) >> 8; int incl = tiles;
#pragma unroll
        for (int d = 1; d < 32; d <<= 1) { const int v = __shfl_up(incl, d); if (e >= d) incl += v; }
        const int excl = incl - tiles;
        if (e < NEXP) { tab[1 + e] = excl * 256; for (int i = 0; i < tiles; ++i) tab[64 + excl + i] = e; }
        if (e == NEXP - 1) { tab[33] = incl * 256; tab[0] = incl; } }
    __syncthreads();
}
constexpr int GTAB_OFF = LDSCTL_OFF + 2048;
template <class Sched> __device__ __forceinline__ void moe_gather_table(Frame& F, const Sched& S, const int* rowtok) {
    LAS unsigned* gtab = (LAS unsigned*)(F.lds + GTAB_OFF);
    int sl[8];
#pragma unroll
    for (int i = 0; i < 8; ++i) { pg8::Unit u; const bool ok = S.next(i, u); sl[i] = (ok && F.tid < 256) ? rowtok[u.pm * 256 + F.tid] : -2; }
#pragma unroll
    for (int i = 0; i < 8; ++i) if (sl[i] != -2) gtab[i * 256 + F.tid] = (unsigned)(sl[i] >= 0 ? (sl[i] >> 1) : 0) * (unsigned)(DM * 2);
    __syncthreads();
}
constexpr int RT_OFF = GTAB_OFF, RW_OFF = GTAB_OFF + 5 * 1024;
template <class Sched> __device__ __forceinline__ void moe_rowmap_table(Frame& F, const Sched& S, const int* rowtok, const float* roww) {
    LAS int* rt = (LAS int*)(F.lds + RT_OFF); LAS float* rw = (LAS float*)(F.lds + RW_OFF);
    int sl[5]; float gw[5]; bool okv[5];
#pragma unroll
    for (int i = 0; i < 5; ++i) { pg8::Unit u; okv[i] = S.next(i, u) && F.tid < 256; sl[i] = okv[i] ? rowtok[u.pm * 256 + F.tid] : -1; gw[i] = okv[i] ? roww[u.pm * 256 + F.tid] : 0.f; }
#pragma unroll
    for (int i = 0; i < 5; ++i) if (okv[i]) { rt[i * 256 + F.tid] = sl[i]; rw[i * 256 + F.tid] = gw[i]; }
    __syncthreads();
}
__device__ __forceinline__ void phase_permute(Frame& F, const Args& a, int layer) {
    unsigned char* ws = F.ws_; moe_tables(F, layer);
    const LAS int* tab = (const LAS int*)(F.lds + MOE_TAB_OFF);
    const int* tok_e = (const int*)(ws + WS_TOK); const int* tok_pos = tok_e + 32768; const float* tok_w = (const float*)(tok_pos + 32768);
    int* rowtok = (int*)(ws + WS_TOK + 3 * 131072); float* roww = (float*)(rowtok + XG_ROWS);
    const bf16* HB = (const bf16*)(ws + WS_HB); bf16* XG = (bf16*)(ws + WS_XG);
    const int gw = blockIdx.x * NWAVES + F.wave, NGW = F.G * NWAVES;
#if MOE_GATHER
    for (int slot = blockIdx.x * NTHR + F.tid; slot < 2 * NTOK; slot += F.G * NTHR) { const int row = tab[1 + tok_e[slot]] + tok_pos[slot]; rowtok[row] = slot; roww[row] = tok_w[slot]; }
    if (0)
#endif
    for (int slot = gw; slot < 2 * NTOK; slot += NGW) {
        const int e = tok_e[slot], row = tab[1 + e] + tok_pos[slot];
        if (F.lane == 0) { rowtok[row] = slot; roww[row] = tok_w[slot]; }
#if !MOE_GATHER
        const u32x4* src = (const u32x4*)(HB + (size_t)(slot >> 1) * DM) + F.lane; u32x4* dst = (u32x4*)(XG + (size_t)row * DM) + F.lane;
#pragma unroll
        for (int j = 0; j < 4; ++j) dst[64 * j] = src[64 * j];
#endif
    }
    if (blockIdx.x < NEXP) { const int e = blockIdx.x, c = (int)__hip_atomic_load(F.ctl + CW_CNT + 64 * layer + e, RLX_AGENT), lo = tab[1 + e] + c, hi = tab[2 + e];
        for (int r = lo + F.tid; r < hi; r += NTHR) { rowtok[r] = -1; roww[r] = 0.f; } }
}
__device__ __forceinline__ void phase_ln2(Frame& F, const Args& a, int layer) {
    unsigned char* ws = F.ws_; const bf16* HB = (const bf16*)(ws + WS_HB); const bf16* HLO = (const bf16*)(ws + WS_HLO); const bf16* FO = (const bf16*)(ws + WS_FOUT); bf16* XB = (bf16*)(ws + WS_XB);
    const float* g = a.in[26] + layer * DM; const float* bta = a.in[27] + layer * DM;
    const int gw = blockIdx.x * NWAVES + F.wave, NGW = F.G * NWAVES;
    f32x4 gv[8], bv[8];
#pragma unroll
    for (int j = 0; j < 8; ++j) { gv[j] = ((const f32x4*)g)[F.lane + 64 * j]; bv[j] = ((const f32x4*)bta)[F.lane + 64 * j]; }
#define LN2_LOAD(S_, row_) do { const int r_ = (row_); const u32x2* hh_ = (const u32x2*)(HB + (size_t)r_ * DM) + F.lane; \
        const u32x2* f0_ = (const u32x2*)(FO + (size_t)(2 * r_) * DM) + F.lane; const u32x2* f1_ = f0_ + DM / 4; \
        _Pragma("unroll") for (int j = 0; j < 8; ++j) { S_[0][j] = hh_[64 * j]; S_[2][j] = f0_[64 * j]; S_[3][j] = f1_[64 * j]; } } while (0)
#define LN2_DO(S_, row_) do { const int r_ = (row_); f32x4 v[8]; \
        _Pragma("unroll") for (int j = 0; j < 8; ++j) { const u32x2 hx = S_[0][j], p = S_[2][j], q = S_[3][j]; f32x4 h; h.x = bflo(hx.x); h.y = bfhi(hx.x); h.z = bflo(hx.y); h.w = bfhi(hx.y); \
            v[j].x = ALPHA * h.x + (bflo(p.x) + bflo(q.x)); v[j].y = ALPHA * h.y + (bfhi(p.x) + bfhi(q.x)); v[j].z = ALPHA * h.z + (bflo(p.y) + bflo(q.y)); v[j].w = ALPHA * h.w + (bfhi(p.y) + bfhi(q.y)); } \
        float mean, rstd; ln_stats(v, mean, rstd); \
        f32x4* outr = (f32x4*)(a.out + (size_t)r_ * DM) + F.lane; u32x2* xb = (u32x2*)(XB + (size_t)r_ * DM) + F.lane; \
        _Pragma("unroll") for (int j = 0; j < 8; ++j) { const f32x4 o = v[j] * rstd * gv[j] + bv[j]; \
            if (layer == 1) outr[64 * j] = o; else { u32x2 w; w.x = cvtpk(o.x, o.y); w.y = cvtpk(o.z, o.w); xb[64 * j] = w; } } } while (0)
    u32x2 sa[4][8], sb[4][8];
    const int nrows = NTOK / NGW; int k = 0;
    LN2_LOAD(sa, gw);
    for (; k + 2 < nrows; k += 2) { LN2_LOAD(sb, gw + (k + 1) * NGW); LN2_DO(sa, gw + k * NGW); LN2_LOAD(sa, gw + (k + 2) * NGW); LN2_DO(sb, gw + (k + 1) * NGW); }
    LN2_LOAD(sb, gw + (k + 1) * NGW); LN2_DO(sa, gw + k * NGW); LN2_DO(sb, gw + (k + 1) * NGW);
#undef LN2_LOAD
#undef LN2_DO
}
namespace attn_body {
using bf16x8=__attribute__((ext_vector_type(8)))short;
using s16x4=__attribute__((ext_vector_type(4)))short;
using f32x16=__attribute__((ext_vector_type(16)))float;
using u32x4=__attribute__((ext_vector_type(4)))unsigned;
constexpr int BATCH=2,NHEAD=16,SEQ=8192,D=64,DM=NHEAD*D;
constexpr int NW=8,QBLK=32,QB=QBLK*NW,KVBLK=64,NQB=SEQ/QB;
constexpr int ATTN_PITCH=DM, ATTN_UNIT_ROWS=QB;
__device__ __forceinline__ int crow(int r,int hi){return (r&3)+8*(r>>2)+4*hi;}
#define SBAR() __builtin_amdgcn_sched_barrier(0)
__device__ __forceinline__ void cmask(f32x16&p0,f32x16&p1,int jb,int qrel,int hi){
  const float NEG=-INFINITY; int kb=64*jb+4*hi;
  #pragma unroll
  for(int r=0;r<16;++r){int kv=kb+(r&3)+8*(r>>2); if(kv>qrel)p0[r]=NEG; if(kv+32>qrel)p1[r]=NEG;}
}

constexpr int NSLOT=3, SLOTB=8192;
constexpr int LDS_K=0, LDS_V=NSLOT*SLOTB, LDS_WS=2*NSLOT*SLOTB, LDS_OST=LDS_WS+NW*64*4, LDS_BYTES=LDS_OST+NW*4096;
constexpr float C2=0.125f*1.4426950408889634f;
__device__ __forceinline__ void glds16(const void*gsrc,unsigned lds_dst){unsigned keep;
  asm volatile("s_mov_b32 %0, m0\n\ts_mov_b32 m0, %2\n\ts_nop 0\n\tglobal_load_lds_dwordx4 %1, off\n\ts_mov_b32 m0, %0":"=&s"(keep):"v"(gsrc),"s"(lds_dst):"memory");}
__device__ __forceinline__ float max3f(float a,float b,float c){float r;asm("v_max3_f32 %0, %1, %2, %3":"=v"(r):"v"(a),"v"(b),"v"(c));return r;}
__device__ __forceinline__ float max2f(float a,float b){float r;asm("v_max_f32_e32 %0, %1, %2":"=v"(r):"v"(a),"v"(b));return r;}
__device__ __forceinline__ float fadd_s(float a,float b){float r;asm("v_add_f32_e32 %0, %1, %2":"=v"(r):"v"(a),"v"(b));return r;}
__device__ __forceinline__ float fsub_s(float a,float b){float r;asm("v_sub_f32_e32 %0, %1, %2":"=v"(r):"v"(a),"v"(b));return r;}
typedef float f32x2_t __attribute__((ext_vector_type(2))); typedef __bf16 bf16x2_t __attribute__((ext_vector_type(2)));
__device__ __forceinline__ unsigned cvtpk_s(float lo,float hi){f32x2_t v={lo,hi};bf16x2_t b=__builtin_convertvector(v,bf16x2_t);return __builtin_bit_cast(unsigned,b);}
#define WAIT_BAR(N) asm volatile("s_waitcnt vmcnt(" #N ") lgkmcnt(0)\n\ts_barrier":::"memory")

__device__ __forceinline__ void qkt(f32x16&p0,f32x16&p1,const char*Kslot,const bf16x8*qr,const f32x16&negm,int r32,int hi){
  const char*kb=Kslot+hi*1024+r32*16;
  #pragma unroll
  for(int d0=0;d0<4;++d0){
    const bf16x8 b0=*reinterpret_cast<const bf16x8*>(kb+d0*2048);
    const bf16x8 b1=*reinterpret_cast<const bf16x8*>(kb+d0*2048+512);
    if(d0==0){p0=__builtin_amdgcn_mfma_f32_32x32x16_bf16(b0,qr[0],negm,0,0,0);p1=__builtin_amdgcn_mfma_f32_32x32x16_bf16(b1,qr[0],negm,0,0,0);}
    else{p0=__builtin_amdgcn_mfma_f32_32x32x16_bf16(b0,qr[d0],p0,0,0,0);p1=__builtin_amdgcn_mfma_f32_32x32x16_bf16(b1,qr[d0],p1,0,0,0);}}
}
typedef __attribute__((address_space(3))) const char* lds_cptr;
typedef short v4i16_t __attribute__((ext_vector_type(4)));
__device__ __forceinline__ void kload8(bf16x8*kf,lds_cptr kp){
  kf[0]=*(const __attribute__((address_space(3))) bf16x8*)(kp);      kf[1]=*(const __attribute__((address_space(3))) bf16x8*)(kp+512);
  kf[2]=*(const __attribute__((address_space(3))) bf16x8*)(kp+2048); kf[3]=*(const __attribute__((address_space(3))) bf16x8*)(kp+2560);
  kf[4]=*(const __attribute__((address_space(3))) bf16x8*)(kp+4096); kf[5]=*(const __attribute__((address_space(3))) bf16x8*)(kp+4608);
  kf[6]=*(const __attribute__((address_space(3))) bf16x8*)(kp+6144); kf[7]=*(const __attribute__((address_space(3))) bf16x8*)(kp+6656);
}
__device__ __forceinline__ void kload2(bf16x8*kf,lds_cptr kp,int j){ kf[2*j]=*(const __attribute__((address_space(3))) bf16x8*)(kp+j*2048); kf[2*j+1]=*(const __attribute__((address_space(3))) bf16x8*)(kp+j*2048+512); }
__device__ __forceinline__ s16x4 vtr(lds_cptr p){ return __builtin_bit_cast(s16x4,__builtin_amdgcn_ds_read_tr16_b64_v4i16((__attribute__((address_space(3))) v4i16_t*)p)); }
__device__ __forceinline__ float rowmax(const f32x16&p0,const f32x16&p1){
  float a=max3f(p0[0],p0[1],p1[0]),b=max3f(p0[2],p0[3],p1[1]);a=max3f(a,p1[2],p1[3]);
  #pragma unroll
  for(int r=4;r<16;r+=4){a=max3f(a,p0[r],p0[r+1]);b=max3f(b,p0[r+2],p0[r+3]);a=max3f(a,p1[r],p1[r+1]);b=max3f(b,p1[r+2],p1[r+3]);}
  const float m=max2f(a,b);
  auto rr=__builtin_amdgcn_permlane32_swap(__float_as_uint(m),__float_as_uint(m),false,false);
  return max2f(__uint_as_float(rr[0]),__uint_as_float(rr[1]));
}
__device__ __forceinline__ void pv(f32x16*o,int vb,bf16x8 pa0,bf16x8 pa1,bf16x8 pa2,bf16x8 pa3){
  #pragma unroll
  for(int d0=0;d0<2;++d0){s16x4 lo[4],hi[4];
    #pragma unroll
    for(int ks=0;ks<4;++ks){
      asm volatile("ds_read_b64_tr_b16 %0,%1 offset:%c2":"=&v"(lo[ks]):"v"(vb),"i"(d0*4096+ks*1024):"memory");
      asm volatile("ds_read_b64_tr_b16 %0,%1 offset:%c2":"=&v"(hi[ks]):"v"(vb),"i"(d0*4096+ks*1024+512):"memory");}
    asm volatile("s_waitcnt lgkmcnt(0)":::"memory");SBAR();
    #define PK(k) (bf16x8){lo[k][0],lo[k][1],lo[k][2],lo[k][3],hi[k][0],hi[k][1],hi[k][2],hi[k][3]}
    o[d0]=__builtin_amdgcn_mfma_f32_32x32x16_bf16(pa0,PK(0),o[d0],0,0,0);
    o[d0]=__builtin_amdgcn_mfma_f32_32x32x16_bf16(pa1,PK(1),o[d0],0,0,0);
    o[d0]=__builtin_amdgcn_mfma_f32_32x32x16_bf16(pa2,PK(2),o[d0],0,0,0);
    o[d0]=__builtin_amdgcn_mfma_f32_32x32x16_bf16(pa3,PK(3),o[d0],0,0,0);
    #undef PK
  }
}

#ifndef ATTN_STORE16
#define ATTN_STORE16(p,v) (*(u32x4*)(p)=(v))
#endif
template<int THRL> __device__ __forceinline__ void attn_unit(int b,int hq,int hv,int ho,int qb,const bf16*Q,const bf16*__restrict__ K,const bf16*__restrict__ V,bf16*O,char*shm){
  int tid_=threadIdx.x; asm volatile("":"+v"(tid_)); const int tid=tid_,lane=tid&63,r32=lane&31,hi=lane>>5; const int wid=__builtin_amdgcn_readfirstlane(tid>>6);
  const long rowbase=(long)b*SEQ; const int q0=qb*QB;
  const bf16*Qw=Q+(rowbase+q0+wid*QBLK)*DM+hq*D;
  const bf16*Kh=K+rowbase*DM+hq*D,*Vh=V+rowbase*DM+hv*D;
  const unsigned lds0=(unsigned)(uintptr_t)shm;
  float*wsf=(float*)(shm+LDS_WS)+wid*64;
  const bf16*ksrc=Kh+(long)lane*DM+wid*8;
  const bf16*vsrc=Vh+(long)(16*(wid&3)+(lane>>2))*DM+(wid>>2)*32+(lane&3)*8;
  const unsigned kdst=lds0+LDS_K+wid*1024, vdst=lds0+LDS_V+wid*1024;
  #define DMA_K(t,slot) glds16(ksrc+(long)(t)*KVBLK*DM,(unsigned)__builtin_amdgcn_readfirstlane(kdst+(slot)))
  #define DMA_V(t,slot) glds16(vsrc+(long)(t)*KVBLK*DM,(unsigned)__builtin_amdgcn_readfirstlane(vdst+(slot)))
  const int vb0=(int)(lds0+LDS_V)+((lane>>4)&1)*32+(lane&3)*8+(4*hi+((lane&15)>>2))*64;
  const char*Kbase=shm+LDS_K; bf16x8 kf[8];
  const lds_cptr shm3=(lds_cptr)shm; const lds_cptr kp0=shm3+LDS_K+hi*1024+r32*16; const lds_cptr vp0=shm3+LDS_V+((lane>>4)&1)*32+(lane&3)*8+(4*hi+((lane&15)>>2))*64;
  const int NT=(q0+QB)/KVBLK;
  DMA_K(0,0);DMA_V(0,0);DMA_K(1,SLOTB);
  bf16x8 qr[4];
  #pragma unroll
  for(int d0=0;d0<4;++d0)qr[d0]=*reinterpret_cast<const bf16x8*>(&Qw[(long)r32*DM+d0*16+hi*8]);
  float mhat=0.f,l_reg=0.f;f32x16 o[2];o[0]=f32x16{};o[1]=f32x16{};f32x16 negm=f32x16{};asm volatile("":"+v"(negm));
  const int qrel=wid*QBLK+r32;
  #define CMASK(P0,P1,t) do{int jb_=(t)-(NT-4); if(jb_>=0)cmask(P0,P1,jb_,qrel,hi);}while(0)
  bool resc=false;
  #define START(P0,P1) do{ const float rm=rowmax(P0,P1); resc=false; \
    { const float dl=rm; mhat=fadd_s(mhat,dl); \
      _Pragma("unroll") for(int r=0;r<16;++r){P0[r]=fsub_s(P0[r],dl);P1[r]=fsub_s(P1[r],dl);} \
      _Pragma("unroll") for(int r=0;r<16;++r)negm[r]=-mhat; asm volatile("":"+v"(negm)); } \
    _Pragma("unroll") for(int r=0;r<16;++r)P0[r]=__builtin_amdgcn_exp2f(P0[r]); }while(0)
  #define RESC() do{ if(resc){ asm volatile("s_waitcnt lgkmcnt(0)":::"memory"); \
      _Pragma("unroll") for(int d_=0;d_<2;++d_) _Pragma("unroll") for(int r=0;r<16;++r)o[d_][r]*=wsf[crow(r,hi)]; } }while(0)
  f32x16 pA0,pA1,pB0,pB1;
  int sl_prev=0,sl_cur=0,sl_next=SLOTB;
  #define ROT() do{sl_prev=sl_cur;sl_cur=sl_next;sl_next=(sl_next==(NSLOT-1)*SLOTB)?0:sl_next+SLOTB;}while(0)
  DMA_K(2,2*SLOTB);
  WAIT_BAR(3);
  qkt(pA0,pA1,Kbase,qr,negm,r32,hi);asm volatile("s_nop 15\n\ts_nop 7":"+v"(pA0),"+v"(pA1));CMASK(pA0,pA1,0);
  START(pA0,pA1);
  _Pragma("unroll") for(int r=0;r<16;++r)pA1[r]=__builtin_amdgcn_exp2f(pA1[r]);
  WAIT_BAR(0);
  DMA_K(3,0);DMA_V(1,SLOTB);
  ROT();
  kload8(kf,kp0+sl_cur);
  WAIT_BAR(2);
  s16x4 vlo[8],vhi[8]; u32x4 pw0,pw1,pw2,pw3;
  #define PKW(P,B) cvtpk_s(P[B],P[B+1])
  #define PAF(k) __builtin_bit_cast(bf16x8,pw##k)
  #define VFR(i) (bf16x8){vlo[i][0],vlo[i][1],vlo[i][2],vlo[i][3],vhi[i][0],vhi[i][1],vhi[i][2],vhi[i][3]}
  #define PIN(x) asm volatile("":"+v"(x))
  #define MX3(a,b,c) __builtin_fmaxf(__builtin_fmaxf((a),(b)),(c))
  #define GAPA(MF,A0,A1,A2,A3,W0,W1,PW) do{ MF; sacc+=A0; sacc+=A1; sacc+=A2; sacc+=A3; PIN(sacc); W0; W1; PIN(PW); SBAR(); }while(0)
  #define EX(v) __builtin_amdgcn_exp2f(v)
  #define GAPB(MF,X,B) do{ MF; X[B]=EX(X[B]); X[B+1]=EX(X[B+1]); X[B+2]=EX(X[B+2]); X[B+3]=EX(X[B+3]); PIN(X); SBAR(); }while(0)
  #define VRD(i) do{ vlo[i]=vtr(vp_+(((i)>>2)*4096+((i)&3)*1024)); vhi[i]=vtr(vp_+(((i)>>2)*4096+((i)&3)*1024+512)); }while(0)
  #define KRD(G,j) do{ if(G){ kload2(kf,kp0+sl_next,j); SBAR(); } }while(0)
  #define STEP(C0,C1,P0,P1,t,GK,GV,GL) do{ SBAR(); \
    const lds_cptr vp_=vp0+sl_prev; \
    VRD(0); SBAR(); float sacc=(P0[0]+P0[1]); \
    GAPA(C0=__builtin_amdgcn_mfma_f32_32x32x16_bf16(kf[0],qr[0],negm,0,0,0), P0[2],P0[3],P0[4],P0[5],     pw0[0]=PKW(P0,0), pw0[1]=PKW(P0,2), pw0); \
    VRD(4); SBAR(); GAPA(C1=__builtin_amdgcn_mfma_f32_32x32x16_bf16(kf[1],qr[0],negm,0,0,0), P0[6],P0[7],P0[8],P0[9],     pw0[2]=PKW(P0,4), pw0[3]=PKW(P0,6), pw0); \
    VRD(1); SBAR(); GAPA(C0=__builtin_amdgcn_mfma_f32_32x32x16_bf16(kf[2],qr[1],C0,0,0,0),   P0[10],P0[11],P0[12],P0[13], pw1[0]=PKW(P0,8), pw1[1]=PKW(P0,10), pw1); \
    VRD(5); SBAR(); GAPA(C1=__builtin_amdgcn_mfma_f32_32x32x16_bf16(kf[3],qr[1],C1,0,0,0),   P0[14],P0[15],P1[0],P1[1],   pw1[2]=PKW(P0,12),pw1[3]=PKW(P0,14), pw1); \
    VRD(2); SBAR(); GAPA(C0=__builtin_amdgcn_mfma_f32_32x32x16_bf16(kf[4],qr[2],C0,0,0,0),   P1[2],P1[3],P1[4],P1[5],     pw2[0]=PKW(P1,0), pw2[1]=PKW(P1,2), pw2); \
    VRD(6); SBAR(); GAPA(C1=__builtin_amdgcn_mfma_f32_32x32x16_bf16(kf[5],qr[2],C1,0,0,0),   P1[6],P1[7],P1[8],P1[9],     pw2[2]=PKW(P1,4), pw2[3]=PKW(P1,6), pw2); \
    VRD(3); SBAR(); GAPA(C0=__builtin_amdgcn_mfma_f32_32x32x16_bf16(kf[6],qr[3],C0,0,0,0),   P1[10],P1[11],P1[12],P1[13], pw3[0]=PKW(P1,8), pw3[1]=PKW(P1,10), pw3); \
    VRD(7); SBAR(); GAPA(C1=__builtin_amdgcn_mfma_f32_32x32x16_bf16(kf[7],qr[3],C1,0,0,0),   P1[14],P1[15],0.f,0.f,       pw3[2]=PKW(P1,12),pw3[3]=PKW(P1,14), pw3); \
    l_reg+=sacc; \
    if(GK){DMA_K((t)+3,sl_cur);} if(GV){DMA_V((t)+1,sl_next);} \
    CMASK(C0,C1,t); \
    { float a=MX3(C0[0],C0[1],C1[0]),b=MX3(C0[2],C0[3],C1[1]); a=MX3(a,C1[2],C1[3]); \
      _Pragma("unroll") for(int r=4;r<16;r+=4){a=MX3(a,C0[r],C0[r+1]);b=MX3(b,C0[r+2],C0[r+3]);a=MX3(a,C1[r],C1[r+1]);b=MX3(b,C1[r+2],C1[r+3]);} \
      float rm=__builtin_fmaxf(a,b); { auto rr=__builtin_amdgcn_permlane32_swap(__float_as_uint(rm),__float_as_uint(rm),false,false); rm=__builtin_fmaxf(__uint_as_float(rr[0]),__uint_as_float(rr[1])); } \
      resc=false; \
      if(__builtin_expect(__any(rm>(float)THRL),0)){ const float dl=__builtin_fmaxf(rm,0.f); mhat+=dl; \
        _Pragma("unroll") for(int r=0;r<16;++r){C0[r]-=dl;C1[r]-=dl;} \
        _Pragma("unroll") for(int r=0;r<16;++r)negm[r]=-mhat; asm volatile("":"+v"(negm)); \
        const float f=__builtin_amdgcn_exp2f(-dl); l_reg*=f; if(hi==0)wsf[r32]=f; resc=true; } } \
    SBAR(); \
    GAPB(o[0]=__builtin_amdgcn_mfma_f32_32x32x16_bf16(PAF(0),VFR(0),o[0],0,0,0), C0,0); \
    GAPB(o[1]=__builtin_amdgcn_mfma_f32_32x32x16_bf16(PAF(0),VFR(4),o[1],0,0,0), C0,4); \
    KRD(GL,0); GAPB(o[0]=__builtin_amdgcn_mfma_f32_32x32x16_bf16(PAF(1),VFR(1),o[0],0,0,0), C0,8); \
    KRD(GL,1); GAPB(o[1]=__builtin_amdgcn_mfma_f32_32x32x16_bf16(PAF(1),VFR(5),o[1],0,0,0), C0,12); \
    KRD(GL,2); GAPB(o[0]=__builtin_amdgcn_mfma_f32_32x32x16_bf16(PAF(2),VFR(2),o[0],0,0,0), C1,0); \
    KRD(GL,3); GAPB(o[1]=__builtin_amdgcn_mfma_f32_32x32x16_bf16(PAF(2),VFR(6),o[1],0,0,0), C1,4); \
    GAPB(o[0]=__builtin_amdgcn_mfma_f32_32x32x16_bf16(PAF(3),VFR(3),o[0],0,0,0), C1,8); \
    GAPB(o[1]=__builtin_amdgcn_mfma_f32_32x32x16_bf16(PAF(3),VFR(7),o[1],0,0,0), C1,12); \
    }while(0)
  int t=1;
  #undef CMASK
  #define CMASK(P0,P1,t) do{}while(0)
  for(;t+5<NT;t+=2){
    STEP(pB0,pB1,pA0,pA1,t,true,true,true);     WAIT_BAR(2); RESC(); ROT();
    STEP(pA0,pA1,pB0,pB1,t+1,true,true,true);   WAIT_BAR(2); RESC(); ROT();
  }
  #undef CMASK
  #define CMASK(P0,P1,t) do{int jb_=(t)-(NT-4); if(jb_>=0)cmask(P0,P1,jb_,qrel,hi);}while(0)
  #define ENDW(tt) do{ if((tt)+3<NT){WAIT_BAR(2);} else if((tt)+2<NT){WAIT_BAR(1);} else {WAIT_BAR(0);} }while(0)
  for(;t+1<NT;t+=2){
    STEP(pB0,pB1,pA0,pA1,t,(t+3<NT),(t+1<NT),(t+1<NT));       ENDW(t);   RESC(); ROT();
    STEP(pA0,pA1,pB0,pB1,t+1,(t+4<NT),(t+2<NT),(t+2<NT));     ENDW(t+1); RESC(); ROT();
  }
  STEP(pB0,pB1,pA0,pA1,NT-1,false,false,false); RESC();
  { float sacc=pB0[0]+pB0[1]; _Pragma("unroll") for(int r=2;r<16;++r)sacc+=pB0[r]; _Pragma("unroll") for(int r=0;r<16;++r)sacc+=pB1[r]; l_reg+=sacc;
    pw0=(u32x4){PKW(pB0,0),PKW(pB0,2),PKW(pB0,4),PKW(pB0,6)};pw1=(u32x4){PKW(pB0,8),PKW(pB0,10),PKW(pB0,12),PKW(pB0,14)};pw2=(u32x4){PKW(pB1,0),PKW(pB1,2),PKW(pB1,4),PKW(pB1,6)};pw3=(u32x4){PKW(pB1,8),PKW(pB1,10),PKW(pB1,12),PKW(pB1,14)};
    SBAR(); pv(o,vb0+sl_cur,PAF(0),PAF(1),PAF(2),PAF(3)); }
  #undef PKW
  #undef PAF
  #undef VFR
  #undef PIN
  #undef MX3
  #undef GAPA
  #undef GAPB
  #undef EX
  #undef VRD
  #undef KRD
  #undef STEP
  #undef ENDW
  {auto rr=__builtin_amdgcn_permlane32_swap(__float_as_uint(l_reg),__float_as_uint(l_reg),false,false);l_reg=__uint_as_float(rr[0])+__uint_as_float(rr[1]);}
  if(hi==0)wsf[32+r32]=l_reg;asm volatile("s_waitcnt lgkmcnt(0)":::"memory");
  float rli[16];
  #pragma unroll
  for(int r=0;r<16;++r)rli[r]=__builtin_amdgcn_rcpf(wsf[32+crow(r,hi)]);
  bf16*Ow=O+(rowbase+q0+wid*QBLK)*(2*DM)+ho*D;
  { bf16*stg=(bf16*)(shm+LDS_OST)+wid*2048;
    #pragma unroll
    for(int r=0;r<16;++r){const int orow=crow(r,hi);
      #pragma unroll
      for(int d0=0;d0<2;++d0)stg[orow*64+d0*32+r32]=(bf16)f2bf(o[d0][r]*rli[r]);}
    asm volatile("s_waitcnt lgkmcnt(0)":::"memory");
    #pragma unroll
    for(int i=0;i<4;++i){const int row=i*8+(lane>>3),ch=lane&7; const u32x4 v=*(const u32x4*)(stg+row*64+ch*8); ATTN_STORE16(Ow+(long)row*(2*DM)+ch*8,v);} }
  asm volatile("s_waitcnt lgkmcnt(0)\n\ts_barrier":::"memory");
  #undef DMA_K
  #undef DMA_V
  #undef CMASK
  #undef START
  #undef RESC
  #undef ROT
}
}
#undef SBAR
#undef WAIT_BAR
__device__ __forceinline__ void mma_tile(f32x16& acc, const LAS bf16* A, int lda, const LAS bf16* Bt, int ldb, int K, int lane) {
    const LAS bf16* ap = A + (lane & 31) * lda + 8 * (lane >> 5); const LAS bf16* bp = Bt + (lane & 31) * ldb + 8 * (lane >> 5);
#pragma unroll
    for (int k0 = 0; k0 < 8; k0 += 4) { bf16x8 af[4], bf_[4];
#pragma unroll
        for (int k = 0; k < 4; ++k) { af[k] = *(const LAS bf16x8*)(ap + 16 * (k0 + k)); bf_[k] = *(const LAS bf16x8*)(bp + 16 * (k0 + k)); }
        __builtin_amdgcn_sched_barrier(0);
#pragma unroll
        for (int k = 0; k < 4; ++k) acc = __builtin_amdgcn_mfma_f32_32x32x16_bf16(af[k], bf_[k], acc, 0, 0, 0);
        __builtin_amdgcn_sched_barrier(0); }
    (void)K;
}
__device__ __forceinline__ f32x16 zero16() { f32x16 z;
#pragma unroll
    for (int i = 0; i < 16; ++i) z[i] = 0.f;
    return z; }
__device__ __forceinline__ float silu_f(float y) { return y / (1.f + __expf(-y)); }
__device__ __forceinline__ float softplus_f(float x) { return x > 20.f ? x : log1pf(expf(x)); }

constexpr int SP = 136;
constexpr int SSD_CM = 0, SSD_BM = 34816, SSD_XDT = 69632, SSD_XT = 87040, SSD_PM = 104448, SSD_F = 121856;
struct SsdIn { const bf16* XBC; const float* DT; const float* convw; const float* convb; const float* dtb; const float* alog; };

__device__ __forceinline__ void ssd_dt(const SsdIn& I, int t0, int h, LAS float* sdt, LAS float* sac, int wave, int lane) {
    if (wave == 0) {
        const float a = -expf(I.alog[h]), bias = I.dtb[h];
        const float d0 = softplus_f(I.DT[(size_t)(t0 + lane) * 16 + h] + bias), d1 = softplus_f(I.DT[(size_t)(t0 + 64 + lane) * 16 + h] + bias);
        float x0 = d0 * a, x1 = d1 * a;
#pragma unroll
        for (int o = 1; o < 64; o <<= 1) { const float t0_ = __shfl_up(x0, o), t1_ = __shfl_up(x1, o); if (lane >= o) { x0 += t0_; x1 += t1_; } }
        x1 += __shfl(x0, 63);
        sdt[lane] = d0; sdt[64 + lane] = d1; sac[lane] = x0; sac[64 + lane] = x1;
    }
}
__device__ __forceinline__ void ssd_conv8(const bf16* XBC, int b, int s, int ch0, const float (&w)[4][8], const float (&bs)[8], float (&y)[8]) {
#pragma unroll
    for (int q = 0; q < 8; ++q) y[q] = bs[q];
#pragma unroll
    for (int k = 0; k < 4; ++k) { const int ss = s - 3 + k;
        if (ss >= 0) { const u32x4 v = *(const u32x4*)(XBC + ((size_t)b * SEQ + ss) * 1536 + ch0);
            y[0] += w[k][0] * bflo(v.x); y[1] += w[k][1] * bfhi(v.x); y[2] += w[k][2] * bflo(v.y); y[3] += w[k][3] * bfhi(v.y);
            y[4] += w[k][4] * bflo(v.z); y[5] += w[k][5] * bfhi(v.z); y[6] += w[k][6] * bflo(v.w); y[7] += w[k][7] * bfhi(v.w); } }
#pragma unroll
    for (int q = 0; q < 8; ++q) y[q] = silu_f(y[q]);
}
__device__ __forceinline__ void ssd_ldw(const SsdIn& I, int ch0, float (&w)[4][8], float (&bs)[8]) {
#pragma unroll
    for (int k = 0; k < 4; ++k)
#pragma unroll
        for (int q = 0; q < 8; ++q) w[k][q] = I.convw[k * 1536 + ch0 + q];
#pragma unroll
    for (int q = 0; q < 8; ++q) bs[q] = I.convb[ch0 + q];
}

template <int NR> __device__ __forceinline__ void ssd_win_load(const bf16* XBC, int b, int s0, int ch0, u32x4 (&raw)[NR + 3]) {
#pragma unroll
    for (int k = 0; k < NR + 3; ++k) { const int ss = s0 - 3 + k; raw[k] = (ss >= 0) ? *(const u32x4*)(XBC + ((size_t)b * SEQ + ss) * 1536 + ch0) : (u32x4){0u, 0u, 0u, 0u}; }
}
template <int NR> __device__ __forceinline__ void ssd_win_conv(const u32x4 (&raw)[NR + 3], int j, const float (&w)[4][8], const float (&bs)[8], float (&y)[8]) {
#pragma unroll
    for (int q = 0; q < 8; ++q) y[q] = bs[q];
#pragma unroll
    for (int k = 0; k < 4; ++k) { const u32x4 v = raw[j + k];
        y[0] += w[k][0] * bflo(v.x); y[1] += w[k][1] * bfhi(v.x); y[2] += w[k][2] * bflo(v.y); y[3] += w[k][3] * bfhi(v.y);
        y[4] += w[k][4] * bflo(v.z); y[5] += w[k][5] * bfhi(v.z); y[6] += w[k][6] * bflo(v.w); y[7] += w[k][7] * bfhi(v.w); }
#pragma unroll
    for (int q = 0; q < 8; ++q) y[q] = silu_f(y[q]);
}

__device__ __forceinline__ void ssd_dt8(const SsdIn& I, int t0, int g, LAS float* sdt, LAS float* sac, int wave, int lane) {
    const int h = 8 * g + wave;
    const float a = -expf(I.alog[h]), bias = I.dtb[h];
    const float d0 = softplus_f(I.DT[(size_t)(t0 + lane) * 16 + h] + bias), d1 = softplus_f(I.DT[(size_t)(t0 + 64 + lane) * 16 + h] + bias);
    float x0 = d0 * a, x1 = d1 * a;
#pragma unroll
    for (int o = 1; o < 64; o <<= 1) { const float t0_ = __shfl_up(x0, o), t1_ = __shfl_up(x1, o); if (lane >= o) { x0 += t0_; x1 += t1_; } }
    x1 += __shfl(x0, 63);
    sdt[wave * 128 + lane] = d0; sdt[wave * 128 + 64 + lane] = d1; sac[wave * 128 + lane] = x0; sac[wave * 128 + 64 + lane] = x1;
}
constexpr int SSD_F8 = 121856;
__device__ __forceinline__ void phase_ssd_states(Frame& F, const SsdIn& I, bf16* ST, float* CDEC) {
    LAS bf16* XDT = (LAS bf16*)(F.lds + SSD_XDT); LAS bf16* BT = (LAS bf16*)(F.lds + SSD_BM);
    LAS float* sdt = (LAS float*)(F.lds + SSD_F8); LAS float* sac = sdt + 1024;
    const int tid = F.tid, lane = F.lane, wave = F.wave;
    for (int ug = blockIdx.x; ug < BATCH * 64 * 2; ug += F.G) {
        const int g = ug & 1, c = (ug >> 1) & 63, b = ug >> 7, t0 = b * SEQ + c * 128;
        const int lx = 2 * (tid >> 3), n0 = (tid & 15) * 8, chb = 1024 + g * 128 + n0, lb4 = 4 * (tid >> 4);
        u32x4 rb[7]; ssd_win_load<4>(I.XBC, b, c * 128 + lb4, chb, rb);
        u32x4 rx[5]; ssd_win_load<2>(I.XBC, b, c * 128 + lx, (8 * g) * 64 + (tid & 7) * 8, rx);
        ssd_dt8(I, t0, g, sdt, sac, wave, lane);
        { float w[4][8], bs[8]; ssd_ldw(I, chb, w, bs);
#pragma unroll
          for (int j = 0; j < 4; ++j) { float y[8]; ssd_win_conv<4>(rb, j, w, bs, y);
#pragma unroll
              for (int q = 0; q < 8; ++q) BT[(n0 + q) * SP + lb4 + j] = (bf16)f2bf(y[q]); } }
        __syncthreads();
        for (int hh = 0; hh < 8; ++hh) {
            const int h = 8 * g + hh, chx = h * 64 + (tid & 7) * 8, u = ((b * 64 + c) * 16) + h;
            const float alast = sac[hh * 128 + 127];
            { float w[4][8], bs[8]; ssd_ldw(I, chx, w, bs);
#pragma unroll
              for (int j = 0; j < 2; ++j) { float y[8]; ssd_win_conv<2>(rx, j, w, bs, y); const int l = lx + j; const float d = sdt[hh * 128 + l] * __expf(alast - sac[hh * 128 + l]);
#pragma unroll
                  for (int q = 0; q < 8; ++q) XDT[((tid & 7) * 8 + q) * SP + l] = (bf16)f2bf(y[q] * d); } }
            if (hh < 7) ssd_win_load<2>(I.XBC, b, c * 128 + lx, (h + 1) * 64 + (tid & 7) * 8, rx);
            __syncthreads();
            { const int pb = wave & 1, nb = wave >> 1; f32x16 acc = zero16();
              mma_tile(acc, XDT + pb * 32 * SP, SP, BT + nb * 32 * SP, SP, 128, lane);
              bf16* dst = ST + (size_t)u * 8192 + nb * 32 + (lane & 31);
#pragma unroll
              for (int r = 0; r < 16; ++r) dst[(pb * 32 + crow(r, lane >> 5)) * 128] = (bf16)f2bf(acc[r]); }
            if (tid == 0) CDEC[u] = __expf(alast);
            __syncthreads();
        }
    }
}
__device__ __forceinline__ void phase_ssd_scan(Frame& F, bf16* ST, const float* CDEC) {
    for (int e = blockIdx.x * NTHR + F.tid; e < BATCH * 16 * 4096; e += F.G * NTHR) {
        const int pn = (e & 4095) * 2, h = (e >> 12) & 15, b = e >> 16;
        unsigned* p = (unsigned*)(ST + ((size_t)b * 64 * 16 + h) * 8192 + pn); const float* dc = CDEC + b * 64 * 16 + h;
        float h0 = 0.f, h1 = 0.f;
        for (int c0 = 0; c0 < 64; c0 += 16) { unsigned sv[16]; float d[16];
#pragma unroll
            for (int i = 0; i < 16; ++i) { sv[i] = p[(size_t)(c0 + i) * 16 * 4096]; d[i] = dc[(c0 + i) * 16]; }
#pragma unroll
            for (int i = 0; i < 16; ++i) { p[(size_t)(c0 + i) * 16 * 4096] = pk2(h0, h1); h0 = h0 * d[i] + bflo(sv[i]); h1 = h1 * d[i] + bfhi(sv[i]); } }
    }
}
__device__ __forceinline__ void phase_ssd_out(Frame& F, const SsdIn& I, const bf16* ST, const bf16* Z, const float* Dskip, bf16* YS) {
    LAS bf16* Cm = (LAS bf16*)(F.lds + SSD_CM); LAS bf16* Bm = (LAS bf16*)(F.lds + SSD_BM); LAS bf16* XDT = (LAS bf16*)(F.lds + SSD_XDT); LAS bf16* XT = (LAS bf16*)(F.lds + SSD_XT); LAS bf16* Pm = (LAS bf16*)(F.lds + SSD_PM);
    LAS float* sdt = (LAS float*)(F.lds + SSD_F8); LAS float* sac = sdt + 1024;
    const int tid = F.tid, lane = F.lane, wave = F.wave, hi = lane >> 5;
    for (int ug = blockIdx.x; ug < BATCH * 64 * 2; ug += F.G) {
        const int g = ug & 1, c = (ug >> 1) & 63, b = ug >> 7, t0 = b * SEQ + c * 128;
        const int lx = 2 * (tid >> 3), n0 = (tid & 15) * 8, chb = 1024 + g * 128 + n0, chc = chb + 256, lb4 = 4 * (tid >> 4);
        u32x4 rb[7], rc[7]; ssd_win_load<4>(I.XBC, b, c * 128 + lb4, chb, rb); ssd_win_load<4>(I.XBC, b, c * 128 + lb4, chc, rc);
        u32x4 rx[5]; ssd_win_load<2>(I.XBC, b, c * 128 + lx, (8 * g) * 64 + (tid & 7) * 8, rx);
        const u32x4* stsrc = (const u32x4*)(ST + (size_t)(((b * 64 + c) * 16) + 8 * g) * 8192 + (tid >> 3) * 128 + (tid & 7) * 16);
        u32x4 pa0 = stsrc[0], pa1 = stsrc[1];
        ssd_dt8(I, t0, g, sdt, sac, wave, lane);
        { float w[4][8], bs[8]; ssd_ldw(I, chb, w, bs);
#pragma unroll
          for (int j = 0; j < 4; ++j) { float y[8]; ssd_win_conv<4>(rb, j, w, bs, y);
              u32x4 o; o.x = cvtpk(y[0], y[1]); o.y = cvtpk(y[2], y[3]); o.z = cvtpk(y[4], y[5]); o.w = cvtpk(y[6], y[7]); *(LAS u32x4*)(Bm + (lb4 + j) * SP + n0) = o; } }
        { float w[4][8], bs[8]; ssd_ldw(I, chc, w, bs);
#pragma unroll
          for (int j = 0; j < 4; ++j) { float y[8]; ssd_win_conv<4>(rc, j, w, bs, y);
              u32x4 o; o.x = cvtpk(y[0], y[1]); o.y = cvtpk(y[2], y[3]); o.z = cvtpk(y[4], y[5]); o.w = cvtpk(y[6], y[7]); *(LAS u32x4*)(Cm + (lb4 + j) * SP + n0) = o; } }
        __syncthreads();
        const int lb = wave & 3;
        f32x16 cb[2];
#pragma unroll
        for (int k = 0; k < 2; ++k) { const int sb = (wave >> 2) + 2 * k; cb[k] = zero16(); if (sb <= lb) mma_tile(cb[k], Cm + lb * 32 * SP, SP, Bm + sb * 32 * SP, SP, 128, lane); }
        __syncthreads();
        for (int hh = 0; hh < 8; ++hh) {
            const int h = 8 * g + hh, chx = h * 64 + (tid & 7) * 8;
            const LAS float* ac = sac + hh * 128;
#pragma unroll
            for (int k = 0; k < 2; ++k) { const int sb = (wave >> 2) + 2 * k, sidx = sb * 32 + (lane & 31); const float as = ac[sidx];
#pragma unroll
                for (int r = 0; r < 16; ++r) { const int l = lb * 32 + crow(r, hi); const float wv = (sb <= lb && sidx <= l) ? cb[k][r] * __expf(ac[l] - as) : 0.f; Bm[l * SP + sidx] = (bf16)f2bf(wv); } }
            { float w[4][8], bs[8]; ssd_ldw(I, chx, w, bs);
#pragma unroll
              for (int j = 0; j < 2; ++j) { float y[8]; ssd_win_conv<2>(rx, j, w, bs, y); const int l = lx + j; const float d = sdt[hh * 128 + l];
#pragma unroll
                  for (int q = 0; q < 8; ++q) { XDT[((tid & 7) * 8 + q) * SP + l] = (bf16)f2bf(y[q] * d); XT[((tid & 7) * 8 + q) * SP + l] = (bf16)f2bf(y[q]); } } }
            { const int p = tid >> 3, pn0 = (tid & 7) * 16;
              *(LAS u32x4*)(Pm + p * SP + pn0) = pa0; *(LAS u32x4*)(Pm + p * SP + pn0 + 8) = pa1; }
            if (hh < 7) { ssd_win_load<2>(I.XBC, b, c * 128 + lx, (h + 1) * 64 + (tid & 7) * 8, rx);
                const u32x4* nsrc = stsrc + (size_t)(hh + 1) * 1024; pa0 = nsrc[0]; pa1 = nsrc[1]; }
            __syncthreads();
            { const int pb = wave >> 2; f32x16 a1 = zero16(), a2 = zero16();
              mma_tile(a1, Bm + lb * 32 * SP, SP, XDT + pb * 32 * SP, SP, 128, lane);
              mma_tile(a2, Cm + lb * 32 * SP, SP, Pm + pb * 32 * SP, SP, 128, lane);
              const int p = pb * 32 + (lane & 31); const float dsk = Dskip[h];
              bf16 zr[16];
#pragma unroll
              for (int r = 0; r < 16; ++r) zr[r] = Z[(size_t)(t0 + lb * 32 + crow(r, hi)) * 1024 + h * 64 + p];
#pragma unroll
              for (int r = 0; r < 16; ++r) { const int l = lb * 32 + crow(r, hi); const size_t o = (size_t)(t0 + l) * 1024 + h * 64 + p;
                  const float y = a1[r] + __expf(ac[l]) * a2[r] + dsk * bf2f(XT[p * SP + l]); const float z = bf2f(zr[r]);
                  YS[o] = (bf16)f2bf(y * silu_f(z)); } }
            __syncthreads();
        }
    }
}
__device__ __forceinline__ void phase_post0(Frame& F, const Args& a, const bf16* OV, const bf16* YS, bf16* YMIX) {
    const int lane = F.lane;
    const float lam = expf(wave_sum(a.in[5][lane] * a.in[6][lane])) - expf(wave_sum(a.in[7][lane] * a.in[8][lane])) + 0.2f;
    const float g0 = a.in[9][2 * lane] * 0.8f, g1 = a.in[9][2 * lane + 1] * 0.8f;
    const int gw = blockIdx.x * NWAVES + F.wave, NGW = F.G * NWAVES;
#define POST_LOAD(P0, P1, YV, tt) do { const unsigned* ov_ = (const unsigned*)(OV + (size_t)(tt) * 2048); \
        _Pragma("unroll") for (int h = 0; h < 8; ++h) { P0[h] = ov_[h * 128 + lane]; P1[h] = ov_[h * 128 + 64 + lane]; } \
        _Pragma("unroll") for (int gq = 0; gq < 2; ++gq) YV[gq] = *(const u32x4*)(YS + (size_t)(tt) * 1024 + gq * 512 + lane * 8); } while (0)
#define POST_DO(P0, P1, YV, tt) do { unsigned* ym = (unsigned*)(YMIX + (size_t)(tt) * 2048); \
        _Pragma("unroll") for (int h = 0; h < 8; ++h) { const unsigned p0 = P0[h], p1 = P1[h]; \
            const float d0 = bflo(p0) - lam * bflo(p1), d1 = bfhi(p0) - lam * bfhi(p1); \
            const float rs = 1.f / sqrtf(wave_sum(d0 * d0 + d1 * d1) * (1.f / 128.f) + 1e-5f); \
            ym[h * 64 + lane] = pk2(d0 * rs * g0, d1 * rs * g1); } \
        _Pragma("unroll") for (int gq = 0; gq < 2; ++gq) { const u32x4 v = YV[gq]; \
            float y[8] = {bflo(v.x), bfhi(v.x), bflo(v.y), bfhi(v.y), bflo(v.z), bfhi(v.z), bflo(v.w), bfhi(v.w)}; float ss = 0.f; \
            _Pragma("unroll") for (int q = 0; q < 8; ++q) ss += y[q] * y[q]; \
            const float rs = 1.f / sqrtf(wave_sum(ss) * (1.f / 512.f) + 1e-5f); const f32x4 n0 = ng[gq][0], n1 = ng[gq][1]; \
            u32x4 o; o.x = pk2(y[0] * rs * n0.x, y[1] * rs * n0.y); o.y = pk2(y[2] * rs * n0.z, y[3] * rs * n0.w); o.z = pk2(y[4] * rs * n1.x, y[5] * rs * n1.y); o.w = pk2(y[6] * rs * n1.z, y[7] * rs * n1.w); \
            *(u32x4*)(YMIX + (size_t)(tt) * 2048 + 1024 + gq * 512 + lane * 8) = o; } } while (0)
    f32x4 ng[2][2];
#pragma unroll
    for (int gq = 0; gq < 2; ++gq) { ng[gq][0] = *(const f32x4*)(a.in[15] + gq * 512 + lane * 8); ng[gq][1] = *(const f32x4*)(a.in[15] + gq * 512 + lane * 8 + 4); }
    unsigned a0[8], a1[8], b0[8], b1[8]; u32x4 ay[2], by[2];
    int t = gw; if (t >= NTOK) return;
    POST_LOAD(a0, a1, ay, t);
    while (true) {
        const int t1 = t + NGW, t1c = t1 < NTOK ? t1 : t;
        POST_LOAD(b0, b1, by, t1c);
        POST_DO(a0, a1, ay, t);
        if (t1 >= NTOK) break;
        const int t2 = t1 + NGW, t2c = t2 < NTOK ? t2 : t1;
        POST_LOAD(a0, a1, ay, t2c);
        POST_DO(b0, b1, by, t1);
        if (t2 >= NTOK) break;
        t = t2;
    }
#undef POST_LOAD
#undef POST_DO
}
__device__ __forceinline__ void phase_diffattn(Frame& F, const Args& a, const bf16* Q, const bf16* K, const bf16* V, bf16* OV) {
    const int s = F.vcu & 7;
    for (int i = 0; i < 8; ++i) {
        const int bh = (F.vcu >> 3) + 32 * (i >> 2);
        if (bh < 64) {
            const int b = bh >> 5, vh = bh & 31, h = vh >> 2, c = (vh >> 1) & 1, vhalf = vh & 1, ii = i & 3;
            const int qb = (ii == 0) ? s : (ii == 1) ? 15 - s : (ii == 2) ? 16 + s : 31 - s;
            attn_body::attn_unit<8>(b, 2 * h + c, 2 * h + vhalf, vh, qb, Q, K, V, OV, (char*)F.lds);
        }
#if MOE_CVT_IN_ATTN
        if (i == s) { tr_moe_layer(F, a, 0); __syncthreads(); }
#endif
    }
}
constexpr int CMP_HS = 0, CMP_W2 = 17408;
struct CmpA { const bf16* src; const float* pe; int r0;
    struct Raw { bf16x8 x; f32x4 p0, p1; };
    __device__ __forceinline__ Raw raw(int r, int kc) const { Raw q; q.x = *(const bf16x8*)(src + (size_t)(r0 + r) * 2048 + kc * 8); q.p0 = *(const f32x4*)(pe + kc * 8); q.p1 = *(const f32x4*)(pe + kc * 8 + 4); return q; }
    __device__ __forceinline__ bf16x8 fin(const Raw& q, int) const { const u32x4 v = __builtin_bit_cast(u32x4, q.x); const f32x4 p0 = q.p0, p1 = q.p1;
        u32x4 o; o.x = pk2(bflo(v.x) + p0.x, bfhi(v.x) + p0.y); o.y = pk2(bflo(v.y) + p0.z, bfhi(v.y) + p0.w); o.z = pk2(bflo(v.z) + p1.x, bfhi(v.z) + p1.y); o.w = pk2(bflo(v.w) + p1.z, bfhi(v.w) + p1.w);
        return __builtin_bit_cast(bf16x8, o); } };
struct RowsB { const bf16* w; int ld;
    __device__ __forceinline__ bf16x8 operator()(int r, int kc) const { return *(const bf16x8*)(w + (size_t)r * ld + kc * 8); } };
struct RowsA { const bf16* a; int ld; int r0; typedef bf16x8 Raw;
    __device__ __forceinline__ bf16x8 raw(int r, int kc) const { return *(const bf16x8*)(a + (size_t)(r0 + r) * ld + kc * 8); }
    __device__ __forceinline__ bf16x8 fin(bf16x8 x, int) const { return x; } };
__device__ __forceinline__ float gelu_tanh(float x) { const float u = 0.7978845608028654f * (x + 0.044715f * x * x * x); const float th = 1.f - 2.f / (1.f + __expf(2.f * u)); return 0.5f * x * (1.f + th); }

__device__ __forceinline__ void phase_nsa_prep(Frame& F, const Args& a) {
    unsigned char* ws = F.ws_;
    const int tid = F.tid, lane = F.lane, wave = F.wave, hi = lane >> 5, wr = wave & 1, wc = wave >> 1;
    for (int u = blockIdx.x; u < 128; u += F.G) {
        const int kv = u & 1, rt = u >> 1, r0 = rt * 64;
        CmpA af{(const bf16*)(ws + WS_MIX + (kv ? MY_VC : MY_KC)), kv ? a.in[19] : a.in[18], r0}; RowsB bfn{(const bf16*)(ws + (kv ? WS_W1VT : WS_W1KT)), 4096};
        const f32x16 acc = small_gemm<4, 2>(F.lds, 4096, af, bfn, tid);
        LAS bf16* Hs = (LAS bf16*)(F.lds + CMP_HS); LAS bf16* W2 = (LAS bf16*)(F.lds + CMP_W2);
#pragma unroll
        for (int r = 0; r < 16; ++r) Hs[(wr * 32 + crow(r, hi)) * 136 + wc * 32 + (lane & 31)] = (bf16)f2bf(gelu_tanh(acc[r]));
        { const bf16* w2 = (const bf16*)(ws + (kv ? WS_W2VT : WS_W2KT));
#pragma unroll
          for (int i = 0; i < 4; ++i) { const int c = tid + NTHR * i, n = c >> 4, kc = c & 15; *(LAS u32x4*)(W2 + n * 136 + kc * 8) = *(const u32x4*)(w2 + n * 128 + kc * 8); } }
        __syncthreads();
        f32x16 o2 = zero16();
        mma_tile(o2, Hs + wr * 32 * 136, 136, W2 + wc * 32 * 136, 136, 128, lane);
        const int n = wc * 32 + (lane & 31);
        if (kv == 0) { bf16* dst = (bf16*)(ws + WS_MIX + MY_KCMP);
#pragma unroll
            for (int r = 0; r < 16; ++r) dst[(size_t)(r0 + wr * 32 + crow(r, hi)) * 128 + n] = (bf16)f2bf(o2[r]); }
        else { bf16* dst = (bf16*)(ws + WS_MIX + MY_VCT);
#pragma unroll
            for (int r = 0; r < 16; ++r) { const int R = r0 + wr * 32 + crow(r, hi), bg = R >> 9, nr = R & 511; dst[((size_t)bg * 128 + n) * 512 + nr] = (nr == 511) ? (bf16)0 : (bf16)f2bf(o2[r]); } }
        __syncthreads();
    }
    for (int u = (F.G == 256) ? ((int)blockIdx.x - 128) * 2 : (int)blockIdx.x, ue = (F.G == 256) ? u + 2 : NTOK / 64, ustep = (F.G == 256) ? 1 : F.G; u >= 0 && u < ue; u += ustep) {
        const int r0 = u * 64;
        RowsA af{(const bf16*)(ws + WS_XB), 2048, r0}; RowsB bfn{(const bf16*)(ws + WS_WGT), 2048};
        const f32x16 acc = small_gemm<4, 2>(F.lds, 2048, af, bfn, tid);
        const int col = wc * 32 + (lane & 31); float* G = (float*)(ws + WS_MIX + MY_GATES);
        if (col < 48) {
#pragma unroll
            for (int r = 0; r < 16; ++r) G[(size_t)(r0 + wr * 32 + crow(r, hi)) * 48 + col] = 1.f / (1.f + __expf(-acc[r])); }
    }
}

constexpr int NKP = 136, NVP = 68;
constexpr int NSA_KT = 0, NSA_VT = 34816, NSA_IMP = 71680, NSA_SELM = 104448, NSA_WM = 105472;
struct NsaT { const bf16* Q; const bf16* KCMP; const bf16* VCT; const bf16* KS; const bf16* VST; const bf16* KW; const bf16* VWT; const float* GATES; bf16* O; bf16* OC; bf16* OS; };

__device__ __forceinline__ int next_bit128(unsigned long long lo, unsigned long long hi, int from) {
    if (from < 64) { const unsigned long long x = lo & (~0ull << from); if (x) return __builtin_ctzll(x); from = 64; }
    if (from < 128) { const unsigned long long x = hi & (~0ull << (from - 64)); if (x) return 64 + __builtin_ctzll(x); }
    return 128;
}
template <int MODE>
__device__ __forceinline__ void nsa_pass(Frame& F, const bf16* Kb, const bf16* VTb, const int vpitch, const int qb, const int first, const int last, const unsigned long long um_lo, const unsigned long long um_hi,
                                         const unsigned long long wm_lo, const unsigned long long wm_hi, const unsigned long long sm_lo, const unsigned long long sm_hi,
                                         const bf16x8 (&qf)[8], float& m, float& l, f32x16 (&o)[4], const float inv_l, const int tl, const int t,
                                         u32x4 (&kr)[2], u32x4 (&vr)[2], const bool pre, const bf16* Kn, const bf16* Vn, const int vpn, const int tn) {
    int tid_ = threadIdx.x; asm volatile("" : "+v"(tid_));
    const int tid = tid_, lane = tid & 63, q = lane & 31, hi = lane >> 5;
    LAS bf16* KT = (LAS bf16*)(F.lds + NSA_KT); LAS bf16* VT = (LAS bf16*)(F.lds + NSA_VT); LAS float* IMP = (LAS float*)(F.lds + NSA_IMP);
    int cur = (MODE == 2) ? next_bit128(um_lo, um_hi, first) : first;
    auto dummy = 0; (void)dummy;
#define NSA_LOAD(tile) do { const bf16* ks_ = Kb + (size_t)(tile) * 64 * 128; \
        _Pragma("unroll") for (int i_ = 0; i_ < 2; ++i_) { const int c_ = tid + NTHR * i_; kr[i_] = *(const u32x4*)(ks_ + (c_ >> 4) * 128 + (c_ & 15) * 8); } \
        if (MODE != 0) { const bf16* vs_ = VTb + (size_t)(tile) * 64; _Pragma("unroll") for (int i_ = 0; i_ < 2; ++i_) { const int c_ = tid + NTHR * i_; vr[i_] = *(const u32x4*)(vs_ + (size_t)(c_ >> 3) * vpitch + (c_ & 7) * 8); } } } while (0)
#define NSA_WRITE(b_) do { LAS bf16* Kw_ = KT + (b_) * (64 * NKP); LAS bf16* Vw_ = VT + (b_) * (128 * NVP); \
        _Pragma("unroll") for (int i = 0; i < 2; ++i) { const int c = tid + NTHR * i; *(LAS u32x4*)(Kw_ + (c >> 4) * NKP + (c & 15) * 8) = kr[i]; } \
        if (MODE != 0) { _Pragma("unroll") for (int i = 0; i < 2; ++i) { const int c = tid + NTHR * i; LAS u32x2* d = (LAS u32x2*)(Vw_ + (c >> 3) * NVP + (c & 7) * 8); u32x2 a0, a1; a0.x = vr[i].x; a0.y = vr[i].y; a1.x = vr[i].z; a1.y = vr[i].w; d[0] = a0; d[1] = a1; } } } while (0)
    if (!pre) NSA_LOAD(cur);
    NSA_WRITE(0);
    int nxt = (MODE == 2) ? next_bit128(um_lo, um_hi, cur + 1) : cur + 1;
    if (nxt <= last) NSA_LOAD(nxt);
    int buf = 0;
    while (true) {
        LAS bf16* Kt = KT + buf * (64 * NKP); LAS bf16* Vt = VT + buf * (128 * NVP);
        __syncthreads();
        int nn = 1 << 20;
        if (nxt <= last) { NSA_WRITE(buf ^ 1); nn = (MODE == 2) ? next_bit128(um_lo, um_hi, nxt + 1) : nxt + 1; if (nn <= last) NSA_LOAD(nn); }
        else if (Kn != nullptr) { const bf16* ks_ = Kn + (size_t)tn * 64 * 128;
#pragma unroll
            for (int i_ = 0; i_ < 2; ++i_) { const int c_ = tid + NTHR * i_; kr[i_] = *(const u32x4*)(ks_ + (c_ >> 4) * 128 + (c_ & 15) * 8); }
            if (Vn != nullptr) { const bf16* vs_ = Vn + (size_t)tn * 64;
#pragma unroll
                for (int i_ = 0; i_ < 2; ++i_) { const int c_ = tid + NTHR * i_; vr[i_] = *(const u32x4*)(vs_ + (size_t)(c_ >> 3) * vpn + (c_ & 7) * 8); } } }
        bool active = true;
        if (MODE == 2) active = (cur < 64) ? ((wm_lo >> cur) & 1ull) : ((wm_hi >> (cur - 64)) & 1ull);
        if (active) {
            f32x16 sT[2]; sT[0] = zero16(); sT[1] = zero16();
            {
                const LAS bf16* kp = Kt + q * NKP + 8 * hi;
#define NSA_KF(i) (*(const LAS bf16x8*)(kp + ((i) >> 3) * 32 * NKP + 16 * ((i) & 7)))
                bf16x8 kf[4];
#pragma unroll
                for (int i = 0; i < 4; ++i) kf[i] = NSA_KF(i);
                __builtin_amdgcn_sched_barrier(0);
#pragma unroll
                for (int i = 0; i < 16; ++i) { const bf16x8 a = kf[i & 3];
                    if (i + 4 < 16) kf[i & 3] = NSA_KF(i + 4);
                    sT[i >> 3] = __builtin_amdgcn_mfma_f32_32x32x16_bf16(a, qf[i & 7], sT[i >> 3], 0, 0, 0); __builtin_amdgcn_sched_barrier(0); }
#undef NSA_KF
            }
            const bool mysel = (MODE == 2) ? (((cur < 64) ? (sm_lo >> cur) : (sm_hi >> (cur - 64))) & 1ull) != 0ull : true;
            bool need;
            { const int tmin = 64 * qb + 8 * (int)__builtin_amdgcn_readfirstlane(tid >> 6);
              if (MODE <= 1) need = (64 * cur + 63) > ((tmin >= 31) ? ((tmin - 31) >> 4) : -1);
              else if (MODE == 2) need = (cur == qb);
              else need = (cur == qb) || (cur == qb - 8); }
            if (need) {
                int tlo = tl, to = t, hio = hi; asm volatile("" : "+v"(tlo), "+v"(to), "+v"(hio));
#pragma unroll
                for (int half = 0; half < 2; ++half)
#pragma unroll
                    for (int r = 0; r < 16; ++r) { const int kv = 32 * half + crow(r, hio); bool ok;
                        if (MODE <= 1) ok = (64 * cur + kv) <= ((to >= 31) ? ((to - 31) >> 4) : -1);
                        else if (MODE == 2) ok = mysel && (kv <= tlo);
                        else { const int pos = 64 * cur + kv; ok = (pos <= to) && (pos > to - 512); }
                        if (!ok) sT[half][r] = -INFINITY; }
            }
            const bool lane_off = (MODE == 2) && !need && !mysel;
            if (MODE == 1) {
#pragma unroll
                for (int half = 0; half < 2; ++half)
#pragma unroll
                    for (int r = 0; r < 16; ++r) sT[half][r] = fast_exp2(sT[half][r] - m) * inv_l;
#pragma unroll
                for (int half = 0; half < 2; ++half)
#pragma unroll
                    for (int i = 0; i < 4; ++i) { float v = (sT[half][4 * i] + sT[half][4 * i + 1]) + (sT[half][4 * i + 2] + 0.5f * sT[half][4 * i + 3]), w = 0.5f * sT[half][4 * i + 3];
                        v += __shfl_xor(v, 1); w += __shfl_xor(w, 1); v += __shfl_xor(v, 2); w += __shfl_xor(w, 2);
                        const int msel = 16 * cur + 8 * half + 2 * i + hi;
                        if ((q & 3) == 0) { (void)__hip_atomic_fetch_add(&IMP[tl * 128 + msel], v, __ATOMIC_RELAXED, __HIP_MEMORY_SCOPE_WORKGROUP); if (msel + 1 < 128) (void)__hip_atomic_fetch_add(&IMP[tl * 128 + msel + 1], w, __ATOMIC_RELAXED, __HIP_MEMORY_SCOPE_WORKGROUP); } }
            } else {
                float mx = sT[0][0];
#pragma unroll
                for (int r = 1; r < 16; ++r) mx = fmaxf(mx, sT[0][r]);
#pragma unroll
                for (int r = 0; r < 16; ++r) mx = fmaxf(mx, sT[1][r]);
                mx = lane_off ? -INFINITY : mx;
                mx = fmaxf(mx, __shfl_xor(mx, 32));
                const float mn = fmaxf(m, mx), al = fast_exp2(m - mn); m = mn;
                const float msub = lane_off ? INFINITY : mn; const f32x2 ms2 = {msub, msub}; f32x2 ps2 = {0.f, 0.f};
#pragma unroll
                for (int half = 0; half < 2; ++half)
#pragma unroll
                    for (int r = 0; r < 16; r += 2) { const f32x2 sv = {sT[half][r], sT[half][r + 1]}; const f32x2 d = sv - ms2; f32x2 p; p.x = fast_exp2(d.x); p.y = fast_exp2(d.y); sT[half][r] = p.x; sT[half][r + 1] = p.y; ps2 += p; }
                const float ps = ps2.x + ps2.y;
                l = l * al + ps;
                if (MODE >= 2) { if (__any(al != 1.f)) {
#pragma unroll
                    for (int db = 0; db < 4; ++db)
#pragma unroll
                        for (int r = 0; r < 16; ++r) o[db][r] *= al; } }
            }
            if (MODE != 0) {
                bf16x8 pf[4];
#pragma unroll
                for (int ks = 0; ks < 4; ++ks) { const int half = ks >> 1, s8 = (ks & 1) * 8; u32x4 w;
                    w.x = cvtpk(sT[half][s8 + 0], sT[half][s8 + 1]); w.y = cvtpk(sT[half][s8 + 2], sT[half][s8 + 3]); w.z = cvtpk(sT[half][s8 + 4], sT[half][s8 + 5]); w.w = cvtpk(sT[half][s8 + 6], sT[half][s8 + 7]);
                    pf[ks] = __builtin_bit_cast(bf16x8, w); }
                {
                    const LAS bf16* vp = Vt + q * NVP + 4 * hi;
#define NSA_VLO(i) (*(const LAS u32x2*)(vp + ((i) >> 2) * 32 * NVP + 16 * ((i) & 3)))
#define NSA_VHI(i) (*(const LAS u32x2*)(vp + ((i) >> 2) * 32 * NVP + 16 * ((i) & 3) + 8))
                    u32x2 vlo[4], vhi[4];
#pragma unroll
                    for (int i = 0; i < 4; ++i) { vlo[i] = NSA_VLO(i); vhi[i] = NSA_VHI(i); }
                    __builtin_amdgcn_sched_barrier(0);
#pragma unroll
                    for (int i = 0; i < 16; ++i) { u32x4 a; a.x = vlo[i & 3].x; a.y = vlo[i & 3].y; a.z = vhi[i & 3].x; a.w = vhi[i & 3].y;
                        if (i + 4 < 16) { vlo[i & 3] = NSA_VLO(i + 4); vhi[i & 3] = NSA_VHI(i + 4); }
                        o[i >> 2] = __builtin_amdgcn_mfma_f32_32x32x16_bf16(__builtin_bit_cast(bf16x8, a), pf[i & 3], o[i >> 2], 0, 0, 0); __builtin_amdgcn_sched_barrier(0); }
#undef NSA_VLO
#undef NSA_VHI
                }
            }
        }
        if (nxt > last) break;
        cur = nxt; nxt = nn; buf ^= 1;
    }
#undef NSA_LOAD
#undef NSA_WRITE
    __syncthreads();
}

__device__ __forceinline__ void nsa_load_q(bf16x8 (&qf)[8], const bf16* Q, size_t trow, int head, int hi) {
#pragma unroll
    for (int d0 = 0; d0 < 8; ++d0) qf[d0] = *(const bf16x8*)(Q + trow * 2048 + head * 128 + 16 * d0 + 8 * hi);
}
__device__ __forceinline__ void nsa_unit(Frame& F, const NsaT& T, const int b, const int g, const int qb) {
    LAS float* IMP = (LAS float*)(F.lds + NSA_IMP); LAS unsigned long long* SELM = (LAS unsigned long long*)(F.lds + NSA_SELM); LAS unsigned long long* WM = (LAS unsigned long long*)(F.lds + NSA_WM);
    const int bg = b * 4 + g;
    u32x4 kr[2], vr[2];
    bf16x8 qf[8];
    { int tid = threadIdx.x; asm volatile("" : "+v"(tid));
#pragma unroll
      for (int i = 0; i < 16; ++i) IMP[tid + NTHR * i] = 0.f; }
    __syncthreads();
    { int tid = threadIdx.x; asm volatile("" : "+v"(tid)); const int lane = tid & 63, wave = __builtin_amdgcn_readfirstlane(tid >> 6), q = lane & 31, hi = lane >> 5;
      const int tl = 8 * wave + (q >> 2), head = 4 * g + (q & 3), t = 64 * qb + tl; const size_t trow = (size_t)b * SEQ + t;
      nsa_load_q(qf, T.Q, trow, head, hi);
      const int ntc = min(8, (4 * qb + 2) / 64 + 1);
      const bf16* Kc = T.KCMP + (size_t)bg * 512 * 128; const bf16* Vc = T.VCT + (size_t)bg * 128 * 512;
      float m = -1e30f, l = 0.f; f32x16 o[4];
#pragma unroll
      for (int db = 0; db < 4; ++db) o[db] = zero16();
      const float g0 = T.GATES[trow * 48 + head * 3];
      nsa_pass<0>(F, Kc, Vc, 512, qb, 0, ntc - 1, 0ull, 0ull, 0ull, 0ull, 0ull, 0ull, qf, m, l, o, 0.f, tl, t, kr, vr, false, Kc, Vc, 512, 0);
      const float lt = l + __shfl_xor(l, 32); const float inv = lt > 0.f ? 1.f / lt : 0.f;
      nsa_pass<1>(F, Kc, Vc, 512, qb, 0, ntc - 1, 0ull, 0ull, 0ull, 0ull, 0ull, 0ull, qf, m, l, o, inv, tl, t, kr, vr, true, T.KS + (size_t)bg * SEQ * 128, T.VST + (size_t)bg * 128 * SEQ, SEQ, 0);
      bf16* op = T.OC + trow * 2048 + head * 128 + 64 * hi;
#pragma unroll
      for (int p = 0; p < 8; ++p) { const int d0 = (2 * p) >> 2, i0 = (2 * p) & 3, d1 = (2 * p + 1) >> 2, i1 = (2 * p + 1) & 3; u32x4 w;
          w.x = pk2(g0 * o[d0][4 * i0], g0 * o[d0][4 * i0 + 1]); w.y = pk2(g0 * o[d0][4 * i0 + 2], g0 * o[d0][4 * i0 + 3]); w.z = pk2(g0 * o[d1][4 * i1], g0 * o[d1][4 * i1 + 1]); w.w = pk2(g0 * o[d1][4 * i1 + 2], g0 * o[d1][4 * i1 + 3]);
          *(u32x4*)(op + 8 * p) = w; } }
    unsigned long long um_lo = 0ull, um_hi = 0ull, wm_lo = 0ull, wm_hi = 0ull;
    { int tid = threadIdx.x; asm volatile("" : "+v"(tid)); const int lane = tid & 63, wave = __builtin_amdgcn_readfirstlane(tid >> 6);
      unsigned k0[8], k1[8], T[8]; const int m0 = lane, m1 = lane + 64;
#pragma unroll
      for (int it = 0; it < 8; ++it) { const int tk = 8 * wave + it;
          k0[it] = (m0 > qb) ? 0u : ((m0 == 0 || m0 == qb || m0 == qb - 1) ? 0xffffffffu : __float_as_uint(IMP[tk * 128 + m0]) + 1u);
          k1[it] = (m1 > qb) ? 0u : ((m1 == qb || m1 == qb - 1) ? 0xffffffffu : __float_as_uint(IMP[tk * 128 + m1]) + 1u); T[it] = 0u; }
      for (int bit = 31; bit >= 0; --bit) {
#pragma unroll
          for (int it = 0; it < 8; ++it) { const unsigned cand = T[it] | (1u << bit);
              const int cnt = __popcll(__ballot(k0[it] >= cand)) + __popcll(__ballot(k1[it] >= cand));
              if (cnt >= 16) T[it] = cand; } }
      const unsigned long long lt_mask = (1ull << lane) - 1ull, v0 = __ballot(m0 <= qb), v1 = __ballot(m1 <= qb);
#pragma unroll
      for (int it = 0; it < 8; ++it) { const int tk = 8 * wave + it; const unsigned Tt = T[it];
          const unsigned long long gt0 = __ballot(k0[it] > Tt), gt1 = __ballot(k1[it] > Tt), eq0 = __ballot(k0[it] == Tt), eq1 = __ballot(k1[it] == Tt);
          const int need = 16 - __popcll(gt0) - __popcll(gt1), ne0 = __popcll(eq0);
          const unsigned long long keep0 = __ballot(k0[it] == Tt && __popcll(eq0 & lt_mask) < need), keep1 = __ballot(k1[it] == Tt && (ne0 + __popcll(eq1 & lt_mask)) < need);
          if (lane == 0) { SELM[tk * 2] = (gt0 | keep0) & v0; SELM[tk * 2 + 1] = (gt1 | keep1) & v1; } }
      __syncthreads();
#pragma unroll
      for (int i = 0; i < 8; ++i) { wm_lo |= SELM[(8 * wave + i) * 2]; wm_hi |= SELM[(8 * wave + i) * 2 + 1]; }
      if (lane == 0) { WM[wave * 2] = wm_lo; WM[wave * 2 + 1] = wm_hi; }
      __syncthreads();
#pragma unroll
      for (int i = 0; i < 8; ++i) { um_lo |= WM[i * 2]; um_hi |= WM[i * 2 + 1]; }
      um_lo = __builtin_amdgcn_readfirstlane((unsigned)um_lo) | ((unsigned long long)__builtin_amdgcn_readfirstlane((unsigned)(um_lo >> 32)) << 32);
      um_hi = __builtin_amdgcn_readfirstlane((unsigned)um_hi) | ((unsigned long long)__builtin_amdgcn_readfirstlane((unsigned)(um_hi >> 32)) << 32);
      wm_lo = __builtin_amdgcn_readfirstlane((unsigned)wm_lo) | ((unsigned long long)__builtin_amdgcn_readfirstlane((unsigned)(wm_lo >> 32)) << 32);
      wm_hi = __builtin_amdgcn_readfirstlane((unsigned)wm_hi) | ((unsigned long long)__builtin_amdgcn_readfirstlane((unsigned)(wm_hi >> 32)) << 32); }
    { int tid = threadIdx.x; asm volatile("" : "+v"(tid)); const int lane = tid & 63, wave = __builtin_amdgcn_readfirstlane(tid >> 6), q = lane & 31, hi = lane >> 5;
      const int tl = 8 * wave + (q >> 2), head = 4 * g + (q & 3), t = 64 * qb + tl; const size_t trow = (size_t)b * SEQ + t;

      const unsigned long long sm_lo = SELM[tl * 2], sm_hi = SELM[tl * 2 + 1];
      float m = -1e30f, l = 0.f; f32x16 o[4];
#pragma unroll
      for (int db = 0; db < 4; ++db) o[db] = zero16();
      const float gsel = T.GATES[trow * 48 + head * 3 + 1];
      nsa_pass<2>(F, T.KS + (size_t)bg * SEQ * 128, T.VST + (size_t)bg * 128 * SEQ, SEQ, qb, 0, qb, um_lo, um_hi, wm_lo, wm_hi, sm_lo, sm_hi, qf, m, l, o, 0.f, tl, t, kr, vr, true, T.KW + (size_t)bg * SEQ * 128, T.VWT + (size_t)bg * 128 * SEQ, SEQ, max(0, qb - 8));
      const float lt = l + __shfl_xor(l, 32); const float c = lt > 0.f ? gsel / lt : 0.f;
      bf16* op = T.OS + trow * 2048 + head * 128 + 64 * hi;
#pragma unroll
      for (int p = 0; p < 8; ++p) { const int d0 = (2 * p) >> 2, i0 = (2 * p) & 3, d1 = (2 * p + 1) >> 2, i1 = (2 * p + 1) & 3; u32x4 w;
          w.x = pk2(c * o[d0][4 * i0], c * o[d0][4 * i0 + 1]); w.y = pk2(c * o[d0][4 * i0 + 2], c * o[d0][4 * i0 + 3]); w.z = pk2(c * o[d1][4 * i1], c * o[d1][4 * i1 + 1]); w.w = pk2(c * o[d1][4 * i1 + 2], c * o[d1][4 * i1 + 3]);
          *(u32x4*)(op + 8 * p) = w; } }
    { int tid = threadIdx.x; asm volatile("" : "+v"(tid)); const int lane = tid & 63, wave = __builtin_amdgcn_readfirstlane(tid >> 6), q = lane & 31, hi = lane >> 5;
      const int tl = 8 * wave + (q >> 2), head = 4 * g + (q & 3), t = 64 * qb + tl; const size_t trow = (size_t)b * SEQ + t;

      float m = -1e30f, l = 0.f; f32x16 o[4];
#pragma unroll
      for (int db = 0; db < 4; ++db) o[db] = zero16();
      const float gwin = T.GATES[trow * 48 + head * 3 + 2];
      nsa_pass<3>(F, T.KW + (size_t)bg * SEQ * 128, T.VWT + (size_t)bg * 128 * SEQ, SEQ, qb, max(0, qb - 8), qb, 0ull, 0ull, 0ull, 0ull, 0ull, 0ull, qf, m, l, o, 0.f, tl, t, kr, vr, true, nullptr, nullptr, 0, 0);
      const float lt = l + __shfl_xor(l, 32); const float c = lt > 0.f ? gwin / lt : 0.f;
      const size_t offp = trow * 2048 + head * 128 + 64 * hi, offo = trow * 2048 + head * 128 + 8 * hi;
      u32x4 av[8], sv[8];
#pragma unroll
      for (int p = 0; p < 8; ++p) { av[p] = *(const u32x4*)(T.OC + offp + 8 * p); sv[p] = *(const u32x4*)(T.OS + offp + 8 * p); }
#pragma unroll
      for (int p = 0; p < 8; ++p) { const int d0 = (2 * p) >> 2, i0 = (2 * p) & 3, d1 = (2 * p + 1) >> 2, i1 = (2 * p + 1) & 3; const u32x4 a = av[p], s2 = sv[p]; u32x2 wa, wb;
          wa.x = pk2(bflo(a.x) + bflo(s2.x) + c * o[d0][4 * i0], bfhi(a.x) + bfhi(s2.x) + c * o[d0][4 * i0 + 1]); wa.y = pk2(bflo(a.y) + bflo(s2.y) + c * o[d0][4 * i0 + 2], bfhi(a.y) + bfhi(s2.y) + c * o[d0][4 * i0 + 3]);
          wb.x = pk2(bflo(a.z) + bflo(s2.z) + c * o[d1][4 * i1], bfhi(a.z) + bfhi(s2.z) + c * o[d1][4 * i1 + 1]); wb.y = pk2(bflo(a.w) + bflo(s2.w) + c * o[d1][4 * i1 + 2], bfhi(a.w) + bfhi(s2.w) + c * o[d1][4 * i1 + 3]);
          { auto r = __builtin_amdgcn_permlane32_swap(wa.x, wb.x, false, false); wa.x = r[0]; wb.x = r[1]; }
          { auto r = __builtin_amdgcn_permlane32_swap(wa.y, wb.y, false, false); wa.y = r[0]; wb.y = r[1]; }
          u32x4 w; w.x = wa.x; w.y = wa.y; w.z = wb.x; w.w = wb.y;
          *(u32x4*)(T.O + offo + 16 * p) = w; } }
}
__device__ __forceinline__ void phase_nsa_attn(Frame& F, const Args& a) {
    unsigned char* ws = F.ws_;
    const NsaT T{(const bf16*)(ws + WS_MIX + MY_Q), (const bf16*)(ws + WS_MIX + MY_KCMP), (const bf16*)(ws + WS_MIX + MY_VCT), (const bf16*)(ws + WS_MIX + MY_KS), (const bf16*)(ws + WS_MIX + MY_VST),
                 (const bf16*)(ws + WS_MIX + MY_KW), (const bf16*)(ws + WS_MIX + MY_VWT), (const float*)(ws + WS_MIX + MY_GATES), (bf16*)(ws + WS_MIX + MY_ONSA), (bf16*)(ws + WS_XG), (bf16*)(ws + WS_XG + 64 * MiB)};
    const int bgi = F.vcu >> 5, s = F.vcu & 31;
    for (int i = 0; i < 4; ++i) { const int qb = (i == 0) ? s : (i == 1) ? 63 - s : (i == 2) ? 64 + s : 127 - s;
        if (bgi < 8) nsa_unit(F, T, bgi >> 2, bgi & 3, qb);
#if MOE_CVT_IN_ATTN
        if (i == (s & 3)) { __syncthreads(); tr_moe_layer(F, a, 1); __syncthreads(); }
#endif
    }
}
constexpr int NPL = 11, NPHASE = 1 + 2 * NPL;
#ifndef REPEAT_MASK
#define REPEAT_MASK 0ull
#endif
#define IN(k) for (int rep_ = 0, nrep_ = ((lo <= (k) && (k) < hi) ? 1 + (int)((REPEAT_MASK >> (k)) & 1ull) : 0); rep_ < nrep_ && frame_refresh(F, args.wsbase); ++rep_)
#define ws F.ws_
#define SEAM(k) do { if ((k) + 1 < hi) xcd_barrier(bar); } while (0)
template <int layer> __device__ __forceinline__ void layer_phases(Frame& F, const Args& args, const XcdBarrier& bar, const int lo, const int hi) {
        const int pb = 1 + layer * NPL;
        IN((pb + 0)) {
            if constexpr (layer == 0) {
                pg8::Gemm g{(const bf16*)(ws + WS_XB), (const bf16*)(ws + WS_WIN0T), NTOK, EVEN_IN_PAD, DM}; pg8::StaticOrder S; S.init(NTOK, EVEN_IN_PAD, F.G, (int)blockIdx.x);
                pg8::EpiIn0 E{(bf16*)(ws + WS_MIX + MX_Q), (bf16*)(ws + WS_MIX + MX_K), (bf16*)(ws + WS_MIX + MX_V), (bf16*)(ws + WS_MIX + MX_Z), (bf16*)(ws + WS_MIX + MX_XBC), (float*)(ws + WS_MIX + MX_DT), 0.125f * LOG2E};
                pg8::gemm_phase<pg8::EpiIn0, pg8::StaticOrder, true, true>(F.lds, g, S, E);
            } else {
                pg8::Gemm g{(const bf16*)(ws + WS_XB), (const bf16*)(ws + WS_WIN1T), NTOK, ODD_MAIN, DM}; pg8::StaticOrder S; S.init(NTOK, ODD_MAIN, F.G, (int)blockIdx.x);
                pg8::EpiIn1 E{(bf16*)(ws + WS_MIX + MY_Q), (bf16*)(ws + WS_MIX + MY_KC), (bf16*)(ws + WS_MIX + MY_VC), (bf16*)(ws + WS_MIX + MY_KS), (bf16*)(ws + WS_MIX + MY_VST), (bf16*)(ws + WS_MIX + MY_KW), (bf16*)(ws + WS_MIX + MY_VWT),
                              0.08838834764831845f * LOG2E};
                pg8::gemm_phase<pg8::EpiIn1, pg8::StaticOrder, true, true>(F.lds, g, S, E);
            }
            SEAM(pb + 0);
        }
        if constexpr (layer == 0) {
#if ENABLE_MIX0
            IN((pb + 1)) {
                phase_diffattn(F, args, (const bf16*)(ws + WS_MIX + MX_Q), (const bf16*)(ws + WS_MIX + MX_K), (const bf16*)(ws + WS_MIX + MX_V), (bf16*)(ws + WS_MIX + MX_OV));
                const SsdIn I{(const bf16*)(ws + WS_MIX + MX_XBC), (const float*)(ws + WS_MIX + MX_DT), args.in[10], args.in[11], args.in[12], args.in[13]};
                phase_ssd_states(F, I, (bf16*)(ws + WS_MIX + MX_ST), (float*)(ws + WS_MIX + MX_CDEC));
                SEAM(pb + 1);
            }
            IN((pb + 2)) { phase_ssd_scan(F, (bf16*)(ws + WS_MIX + MX_ST), (const float*)(ws + WS_MIX + MX_CDEC)); SEAM(pb + 2); }
            IN((pb + 3)) {
                const SsdIn I{(const bf16*)(ws + WS_MIX + MX_XBC), (const float*)(ws + WS_MIX + MX_DT), args.in[10], args.in[11], args.in[12], args.in[13]};
                phase_ssd_out(F, I, (const bf16*)(ws + WS_MIX + MX_ST), (const bf16*)(ws + WS_MIX + MX_Z), args.in[14], (bf16*)(ws + WS_MIX + MX_YSRAW));
                SEAM(pb + 3);
            }
            IN((pb + 4)) { phase_post0(F, args, (const bf16*)(ws + WS_MIX + MX_OV), (const bf16*)(ws + WS_MIX + MX_YSRAW), (bf16*)(ws + WS_MIX + MX_YMIX)); SEAM(pb + 4); }
#endif
        } else {
#if ENABLE_MIX1
            IN((pb + 1)) { phase_nsa_prep(F, args); SEAM(pb + 1); }
            IN((pb + 2)) { phase_nsa_attn(F, args); SEAM(pb + 2); }
#endif
        }
        IN((pb + 5)) {
            const bf16* A = (layer == 0) ? (const bf16*)(ws + (ENABLE_MIX0 ? WS_MIX + MX_YMIX : WS_END)) : (const bf16*)(ws + (ENABLE_MIX1 ? WS_MIX + MY_ONSA : WS_END)); const bf16* Bt = (const bf16*)(ws + (layer == 0 ? WS_WOUT0T : WS_WOUT1T));
            pg8::Gemm g{A, Bt, NTOK, DM, DM}; pg8::StaticOrder S; S.init(NTOK, DM, F.G, (int)blockIdx.x);
            if constexpr (layer == 0) { pg8::EpiOut E{args.in[0], (bf16*)(ws + WS_R), ALPHA}; pg8::gemm_phase<pg8::EpiOut, pg8::StaticOrder, true, true>(F.lds, g, S, E); }
            else { pg8::EpiOutB E{(const bf16*)(ws + WS_XB), (bf16*)(ws + WS_R), ALPHA}; pg8::gemm_phase<pg8::EpiOutB, pg8::StaticOrder, true, true>(F.lds, g, S, E); }
            SEAM(pb + 5);
        }
        IN((pb + 6)) { phase_ln1_router(F, args, layer); SEAM(pb + 6); }
        IN((pb + 7)) { phase_permute(F, args, layer); SEAM(pb + 7); }
        IN((pb + 8)) {
#if !ONE_LAUNCH
            moe_tables(F, layer);
#endif
            pg8::MoeOrder S{(const LAS int*)(F.lds + MOE_TAB_OFF), F.G, (int)blockIdx.x};
            pg8::EpiMoe1 E{(bf16*)(ws + WS_HID)};
#if MOE_GATHER
            moe_gather_table(F, S, (const int*)(ws + WS_TOK + 3 * 131072));
            pg8::Gemm g{(const bf16*)(ws + WS_HB), (const bf16*)(ws + WS_MOEB1 + (size_t)layer * 256 * MiB), XG_ROWS, NEXP * 2048, DM};
            pg8::gemm_phase<pg8::EpiMoe1, pg8::MoeOrder, true, true, true>(F.lds, g, S, E, (const LAS unsigned*)(F.lds + GTAB_OFF));
#else
            pg8::Gemm g{(const bf16*)(ws + WS_XG), (const bf16*)(ws + WS_MOEB1 + (size_t)layer * 256 * MiB), XG_ROWS, NEXP * 2048, DM};
            pg8::gemm_phase<pg8::EpiMoe1, pg8::MoeOrder, true, true>(F.lds, g, S, E);
#endif
            SEAM(pb + 8);
        }
        IN((pb + 9)) {
#if !ONE_LAUNCH
            moe_tables(F, layer);
#endif
            pg8::Gemm g{(const bf16*)(ws + WS_HID), (const bf16*)(ws + WS_MOEB2 + (size_t)layer * 128 * MiB), XG_ROWS, NEXP * 2048, MOE_FF};
            pg8::MoeOrder S{(const LAS int*)(F.lds + MOE_TAB_OFF), F.G, (int)blockIdx.x};
            moe_rowmap_table(F, S, (const int*)(ws + WS_TOK + 3 * 131072), (const float*)(ws + WS_TOK + 3 * 131072 + XG_ROWS * 4));
            pg8::EpiMoe2 E{(bf16*)(ws + WS_FOUT), (const LAS int*)(F.lds + RT_OFF), (const LAS float*)(F.lds + RW_OFF)};
            pg8::gemm_phase<pg8::EpiMoe2, pg8::MoeOrder, true, true>(F.lds, g, S, E);
            SEAM(pb + 9);
        }
        IN((pb + 10)) { phase_ln2(F, args, layer); SEAM(pb + 10); }
    }
__global__ void __launch_bounds__(NTHR, 2) mega(Args args) {
    extern __shared__ __attribute__((aligned(16))) unsigned char lds_raw[];
    Frame F;
    F.lds = (LAS unsigned char*)lds_raw;
    F.MISC = (volatile LAS unsigned*)(F.lds + MISC_OFF);
    F.tid = threadIdx.x; F.lane = F.tid & 63; F.wave = __builtin_amdgcn_readfirstlane(F.tid >> 6);
    F.G = gridDim.x; { const int bx = blockIdx.x; F.vcu = (F.G % 8 == 0) ? (bx % 8) * (F.G / 8) + bx / 8 : bx; }
    F.ws_ = args.wsbase; F.ctl = (gu32*)(args.wsbase + WS_CTL);
    for (int u = F.tid; u < (LDS_BYTES - LDSCTL_OFF) / 4; u += NTHR) ((LAS unsigned*)(F.lds + LDSCTL_OFF))[u] = 0u;
    __syncthreads();
    const int lo = args.ph_lo, hi = args.ph_hi;
    const bool multi = (hi - lo) > 1;
    XcdBarrier bar; bar.bar = (unsigned*)(F.ctl + CW_BAR); bar.x = 0; bar.st = nullptr;
    if (multi) bar = xcd_barrier_post((unsigned*)(F.ctl + CW_BAR), F.MISC + 8);
    IN((0)) { phase_prologue(F, args); SEAM(0); }

    layer_phases<0>(F, args, bar, lo, hi);
    layer_phases<1>(F, args, bar, lo, hi);
#undef IN
#undef SEAM
#undef ws
}

extern "C" void kernel_launch(void* const* d_in, const int* in_sizes, int n_in, void* d_out, int out_size, void* d_ws, size_t ws_size, hipStream_t stream) {
    static int grid = 0;
    if (grid == 0) {
        if (n_in != 31 || in_sizes[0] != NTOK * DM || out_size != NTOK * DM || ws_size < WS_END) {
            fprintf(stderr, "kernel_launch: unexpected problem: n_in %d in0 %d out %d ws %zu (need %zu); nothing launched\n", n_in, n_in > 0 ? in_sizes[0] : -1, out_size, ws_size, (size_t)WS_END); grid = -1; return; }
        int dev = 0, cus = 0, per_cu = 0;
        if (hipGetDevice(&dev) != hipSuccess || hipDeviceGetAttribute(&cus, hipDeviceAttributeMultiprocessorCount, dev) != hipSuccess) { grid = -1; return; }
        if (hipFuncSetAttribute((const void*)mega, hipFuncAttributeMaxDynamicSharedMemorySize, LDS_BYTES) != hipSuccess) { fprintf(stderr, "kernel_launch: hipFuncSetAttribute failed\n"); grid = -1; return; }
        if (hipOccupancyMaxActiveBlocksPerMultiprocessor(&per_cu, (const void*)mega, NTHR, LDS_BYTES) != hipSuccess || per_cu < 1) fprintf(stderr, "kernel_launch: occupancy query reports %d\n", per_cu);
        (void)hipGetLastError();
        grid = 256;
        if (cus != 256) fprintf(stderr, "kernel_launch: device reports %d CUs; built for 256\n", cus);
    }
    if (grid < 0) return;
    (void)hipMemsetAsync((char*)d_ws + WS_CTL, 0, CTL_ZERO_BYTES, stream);
#if !ENABLE_MIX0 || !ENABLE_MIX1
    if (ws_size >= WS_END + 64 * MiB) (void)hipMemsetAsync((char*)d_ws + WS_END, 0, 64 * MiB, stream);
#endif
    Args a{};
    for (int i = 0; i < 31; ++i) a.in[i] = (const float*)d_in[i];
    a.out = (float*)d_out; a.wsbase = (unsigned char*)d_ws;
#if ONE_LAUNCH
    a.ph_lo = 0; a.ph_hi = NPHASE;
    hipLaunchKernelGGL(mega, dim3(grid), dim3(NTHR), LDS_BYTES, stream, a);
#else
    for (int p = 0; p < NPHASE; ++p) {
        const int k = (p - 1) % NPL, layer = (p - 1) / NPL;
        if (p > 0 && !PHASE_ACTIVE(layer, k)) continue;
        a.ph_lo = p; a.ph_hi = p + 1;
        hipLaunchKernelGGL(mega, dim3(grid), dim3(NTHR), LDS_BYTES, stream, a);
    }
#endif
}
```

```cpp
#include <hip/hip_runtime.h>
#include <cstdio>
#include <cstdint>

#define GAS __attribute__((address_space(1)))
#define LAS __attribute__((address_space(3)))
typedef unsigned short bf16;
typedef short bf16x8 __attribute__((ext_vector_type(8)));
typedef short s16x4 __attribute__((ext_vector_type(4)));
typedef float f32x2 __attribute__((ext_vector_type(2)));
typedef float f32x4 __attribute__((ext_vector_type(4)));
typedef float f32x16 __attribute__((ext_vector_type(16)));
typedef unsigned u32x2 __attribute__((ext_vector_type(2)));
typedef unsigned u32x4 __attribute__((ext_vector_type(4)));
typedef GAS unsigned gu32;

constexpr int BATCH = 2, SEQ = 8192, DM = 2048, NTOK = BATCH * SEQ;
constexpr float ALPHA = 1.4142135623730951f;
constexpr float LN_EPS = 1e-5f;
constexpr int EVEN_IN = 5648, EVEN_IN_PAD = 5888, ODD_IN = 5168, ODD_MAIN = 5120;
constexpr int NEXP = 32, MOE_FF = 1024;
constexpr int XG_ROWS = 40960;
constexpr int NWAVES = 8, NTHR = 512;
constexpr float LOG2E = 1.4426950408889634f;

constexpr size_t MiB = 1u << 20;
constexpr size_t WS_CTL = 0, CTL_ZERO_BYTES = 1 * MiB;
constexpr size_t WS_WIN0T = 2 * MiB, WS_WOUT0T = 26 * MiB, WS_WIN1T = 34 * MiB, WS_WOUT1T = 54 * MiB, WS_WGT = 62 * MiB, WS_WRT3 = 63 * MiB,
                 WS_W1KT = 64 * MiB, WS_W1VT = 65 * MiB, WS_W2KT = 66 * MiB, WS_W2VT = 66 * MiB + 512 * 1024;
constexpr size_t WS_MOEB1 = 68 * MiB, WS_MOEB2 = 580 * MiB;
constexpr size_t WS_R = 836 * MiB, WS_XB = 964 * MiB, WS_HB = 1028 * MiB, WS_HLO = 1092 * MiB, WS_XG = 1156 * MiB, WS_HID = 1316 * MiB, WS_FOUT = 1396 * MiB;
constexpr size_t WS_TOK = 1524 * MiB;
constexpr size_t WS_MIX = 1526 * MiB;
constexpr size_t MX_Q = 0, MX_K = 32 * MiB, MX_V = 64 * MiB, MX_Z = 96 * MiB, MX_XBC = 128 * MiB, MX_DT = 176 * MiB, MX_OV = 177 * MiB, MX_ST = 241 * MiB, MX_CDEC = 305 * MiB,
                 MX_YSRAW = 306 * MiB, MX_YMIX = 338 * MiB;
constexpr size_t MY_Q = 0, MY_KC = 64 * MiB, MY_VC = 81 * MiB, MY_KS = 98 * MiB, MY_KW = 114 * MiB, MY_VST = 130 * MiB, MY_VWT = 146 * MiB, MY_KCMP = 162 * MiB, MY_VCT = 163 * MiB,
                 MY_GATES = 164 * MiB, MY_ONSA = 167 * MiB;
constexpr size_t WS_END = WS_MIX + 402 * MiB;

constexpr int CW_TMO = 0, CW_CODE = 1;
constexpr int CW_BAR = 4096;
constexpr int CW_CNT = 16384;

constexpr int LDS_BYTES = 147456;
constexpr int RING_BYTES = 131072;
constexpr int LDSCTL_OFF = RING_BYTES;
constexpr int MISC_OFF = LDSCTL_OFF;
constexpr int MOE_TAB_OFF = LDSCTL_OFF + 256;

#define RLX_AGENT __ATOMIC_RELAXED, __HIP_MEMORY_SCOPE_AGENT
#define LDS_WAIT() asm volatile("s_waitcnt lgkmcnt(0)" ::: "memory")
#define VM_WAIT() asm volatile("s_waitcnt vmcnt(0)" ::: "memory")
__device__ __forceinline__ unsigned f2bf(float f) { unsigned u = __builtin_bit_cast(unsigned, f); return (u + 0x7fffu + ((u >> 16) & 1u)) >> 16; }
__device__ __forceinline__ unsigned pk2(float lo, float hi) { return f2bf(lo) | (f2bf(hi) << 16); }
__device__ __forceinline__ float bf2f(unsigned b) { return __builtin_bit_cast(float, b << 16); }
__device__ __forceinline__ float bflo(unsigned w) { return __builtin_bit_cast(float, w << 16); }
__device__ __forceinline__ float bfhi(unsigned w) { return __builtin_bit_cast(float, w & 0xffff0000u); }
__device__ __forceinline__ float wave_sum(float v) {
#pragma unroll
    for (int o = 1; o < 64; o <<= 1) v += __shfl_xor(v, o);
    return v;
}
__device__ __forceinline__ float fast_exp2(float x) { return __builtin_amdgcn_exp2f(x); }
__device__ __forceinline__ float fast_rcp(float x) { return __builtin_amdgcn_rcpf(x); }
__device__ __forceinline__ int crow(int r, int hi) { return (r & 3) + 8 * (r >> 2) + 4 * hi; }
#define ONE_LAUNCH 1
#define ENABLE_MIX0 1
#define ENABLE_MIX1 1
#define PHASE_ACTIVE(layer, k) 1
#define MOE_CVT_IN_ATTN 1
#define MOE_GATHER 1
namespace pg8 {
#define PG8_LAS __attribute__((address_space(3)))
typedef unsigned short bf16_t;
constexpr int BM = 256, BK = 64, HALF = 128, HTB = HALF * BK * 2  , STAGE_BYTES = 8 * HTB, NXCD = 8, WGM = 8;

__host__ __device__ __forceinline__ int lds_byte(int r, int c) { const int st = (r >> 4) * 2 + (c >> 5), rr = r & 15, cc = c & 31, ob = rr * 64 + cc * 2; return st * 1024 + (ob ^ (((ob >> 9) & 1) << 5)); }
__host__ __device__ __forceinline__ void stage_rc(int b, int& R, int& C) { const int st = b / 1024, sb = b % 1024, swz = sb ^ (((sb >> 9) & 1) << 5); R = (st >> 1) * 16 + swz / 64; C = (st & 1) * 32 + (swz % 64) / 2; }
__host__ __device__ __forceinline__ int perm32(int rho) { const int n = rho >> 4, i = rho & 15; return 8 * (i >> 2) + 4 * n + (i & 3); }

struct Unit { int pm, pn; };
struct Gemm { const bf16_t* A; const bf16_t* Bt; int M, N, K; };

struct StaticOrder {
    int nM, nN, nwg, G, c;
    __host__ __device__ void init(int M, int N, int G_, int c_) { nM = M / BM; nN = N / BM; nwg = nM * nN; G = G_; c = c_; }
    __host__ __device__ bool next(int i, Unit& u) const {
        const long L = (long)i * G + c; if (L >= nwg) return false;
        int wgid = (int)L; { const int q = nwg / NXCD, r = nwg % NXCD, xcd = wgid % NXCD, off = wgid / NXCD; wgid = (xcd < r ? xcd * (q + 1) : r * (q + 1) + (xcd - r) * q) + off; }
        const int nig = WGM * nN, gid = wgid / nig, fm = gid * WGM, gsz = (nM - fm) < WGM ? (nM - fm) : WGM;
        u.pm = fm + ((wgid % nig) % gsz); u.pn = (wgid % nig) / gsz; return true;
    }
    __device__ __forceinline__ void a_ready(const Unit&) const {}
    __device__ __forceinline__ void done(const Unit&) const {}
};
__device__ __forceinline__ unsigned cvt_pk_bf16(float lo, float hi) { unsigned r; asm volatile("v_cvt_pk_bf16_f32 %0, %1, %2" : "=v"(r) : "v"(lo), "v"(hi)); return r; }
template <class Epi, class Sched, bool ALIGN_EPI = false, bool SP2 = false, bool GATHER = false>
__device__ __forceinline__ void gemm_phase(PG8_LAS unsigned char* lds, const Gemm g, const Sched& S, const Epi& E, const PG8_LAS unsigned* gtab = nullptr) {
    static_assert(!GATHER || SP2, "the gathered A operand is wired into the SP2 loop only");
    int tid_ = threadIdx.x; asm volatile("" : "+v"(tid_));
    const int tid = tid_, wid = __builtin_amdgcn_readfirstlane(tid >> 6), lane = tid & 63, wr = wid >> 2, wc = wid & 3, fr = lane & 15, fq = lane >> 4;
    const int K = g.K, nt = K / BK;
    unsigned voffA[2], voffB[2], CA2[2]; int RA[2];
#pragma unroll
    for (int i = 0; i < 2; ++i) { int R, C; stage_rc(tid * 16 + i * 8192, R, C); const int Rb = Epi::PERM ? ((R & ~31) + perm32(R & 31)) : R;
        voffA[i] = (unsigned)(R * K + C) * 2u; voffB[i] = (unsigned)(Rb * K + C) * 2u; RA[i] = R; CA2[i] = (unsigned)C * 2u; }
    unsigned offC[2][2] = {{0u, 0u}, {0u, 0u}}, offN[2][2] = {{0u, 0u}, {0u, 0u}}, o2[2][2] = {{0u, 0u}, {0u, 0u}};
#define PG8_GOFF(dst, u) do { _Pragma("unroll") for (int h_ = 0; h_ < 2; ++h_) _Pragma("unroll") for (int i_ = 0; i_ < 2; ++i_) dst[h_][i_] = gtab[(u) * 256 + h_ * HALF + RA[i_]] + CA2[i_]; } while (0)
#define PG8_STA(bufoff, ptr, half, OFFS) do { if constexpr (GATHER) { PG8_STAGE(bufoff, ptr, OFFS[half]); } else { PG8_STAGE(bufoff, (ptr) + (half) * hstep, voffA); } } while (0)
    const size_t kstep = (size_t)(BK * 2);
    const size_t hstep = (size_t)HALF * K * 2;
    const size_t tstep = 2 * hstep;
    const unsigned ldsw = (unsigned)wid * 1024u;
    const int aoff = lds_byte(wr * 64 + fr, fq * 8), boff = lds_byte(wc * 32 + fr, fq * 8);
#define PG8_SA(b, h) (((b) * 2 + (h)) * HTB)
#define PG8_SB(b, h) ((4 + (b) * 2 + (h)) * HTB)
#define PG8_STAGE(bufoff, gbase, voff) do { _Pragma("unroll") for (int _i = 0; _i < 2; ++_i) \
        __builtin_amdgcn_global_load_lds((const unsigned*)((const char*)(gbase) + (voff)[_i]), (PG8_LAS unsigned*)(lds + (bufoff) + ldsw + _i * 8192), 16, 0, 0); } while (0)
#define PG8_LDA(dst, b, h) do { _Pragma("unroll") for (int m = 0; m < 4; ++m) _Pragma("unroll") for (int k = 0; k < 2; ++k) dst[m][k] = *(const PG8_LAS bf16x8*)(lds + PG8_SA(b, h) + aoff + m * 2048 + k * 1024); } while (0)
#define PG8_LDB(dst, b, h) do { _Pragma("unroll") for (int n = 0; n < 2; ++n) _Pragma("unroll") for (int k = 0; k < 2; ++k) dst[n][k] = *(const PG8_LAS bf16x8*)(lds + PG8_SB(b, h) + boff + n * 2048 + k * 1024); } while (0)
#define PG8_MMA(ai, bj, At, Bt) do { __builtin_amdgcn_s_setprio(1); _Pragma("unroll") for (int m = 0; m < 4; ++m) _Pragma("unroll") for (int n = 0; n < 2; ++n) _Pragma("unroll") for (int k = 0; k < 2; ++k) \
        acc[ai][bj][m][n] = __builtin_amdgcn_mfma_f32_16x16x32_bf16(Bt[n][k], At[m][k], acc[ai][bj][m][n], 0, 0, 0); __builtin_amdgcn_s_setprio(0); } while (0)
#define PG8_WAIT_V(n) asm volatile("s_waitcnt vmcnt(" #n ")" ::: "memory")
#define PG8_WAIT_L(n) asm volatile("s_waitcnt lgkmcnt(" #n ")" ::: "memory")
#define PG8_BAR __builtin_amdgcn_s_barrier()
#define PG8_SCHED __builtin_amdgcn_sched_barrier(0)
    Unit cur, nxt; int ui = 0;
    if (!S.next(0, cur)) return;
    f32x4 acc[2][2][4][2];
#pragma unroll
    for (int a = 0; a < 2; ++a)
#pragma unroll
        for (int b = 0; b < 2; ++b)
#pragma unroll
            for (int m = 0; m < 4; ++m)
#pragma unroll
                for (int n = 0; n < 2; ++n) acc[a][b][m][n] = (f32x4){0.f, 0.f, 0.f, 0.f};
    bf16x8 At[4][2], B0[2][2], B1[2][2];
    const char* cA = (const char*)g.A + (GATHER ? (size_t)0 : (size_t)cur.pm * tstep); const char* cB = (const char*)g.Bt + (size_t)cur.pn * tstep;
    if constexpr (GATHER) PG8_GOFF(offC, 0);
    S.a_ready(cur);
    if constexpr (SP2) {
        PG8_STAGE(PG8_SB(0, 0), cB, voffB); PG8_STAGE(PG8_SB(0, 1), cB + hstep, voffB); PG8_STA(PG8_SA(0, 0), cA, 0, offC); PG8_STA(PG8_SA(0, 1), cA, 1, offC);
        if (wr == 1) PG8_BAR;
        PG8_WAIT_V(2); PG8_BAR;
        PG8_STAGE(PG8_SB(1, 0), cB + kstep, voffB); PG8_STA(PG8_SA(1, 0), cA + kstep, 0, offC); PG8_STAGE(PG8_SB(1, 1), cB + hstep + kstep, voffB);
        PG8_WAIT_V(6); PG8_BAR;
    } else {
        PG8_STAGE(PG8_SB(0, 0), cB, voffB); PG8_STAGE(PG8_SA(0, 0), cA, voffA); PG8_STAGE(PG8_SB(0, 1), cB + hstep, voffB); PG8_STAGE(PG8_SA(0, 1), cA + hstep, voffA);
        if (wr == 1) PG8_BAR;
        PG8_WAIT_V(4); PG8_BAR;
        PG8_STAGE(PG8_SB(1, 0), cB + kstep, voffB); PG8_STAGE(PG8_SA(1, 0), cA + kstep, voffA); PG8_STAGE(PG8_SB(1, 1), cB + hstep + kstep, voffB);
        PG8_WAIT_V(6); PG8_BAR;
    }
    for (;;) {
        const bool has_next = S.next(ui + 1, nxt);
        const char* nA = (has_next && !GATHER) ? (const char*)g.A + (size_t)nxt.pm * tstep : cA; const char* nB = has_next ? (const char*)g.Bt + (size_t)nxt.pn * tstep : cB;
        if constexpr (GATHER) { if (has_next) PG8_GOFF(offN, ui + 1); }
        for (int t = 0; t < nt; t += 2) {
            const bool last = (t == nt - 2);
            const char* a1 = cA + (size_t)(t + 1) * kstep;
            const char* a2 = last ? nA : cA + (size_t)(t + 2) * kstep; const char* b2 = last ? nB : cB + (size_t)(t + 2) * kstep;
            const char* a3 = a2 + kstep; const char* b3 = b2 + kstep;
            if (last && has_next) S.a_ready(nxt);
            if constexpr (GATHER) {
#pragma unroll
                for (int h_ = 0; h_ < 2; ++h_)
#pragma unroll
                    for (int i_ = 0; i_ < 2; ++i_) o2[h_][i_] = (last && has_next) ? offN[h_][i_] : offC[h_][i_]; }
            if constexpr (SP2) {
            PG8_LDB(B0, 0, 0); PG8_LDB(B1, 0, 1); PG8_SCHED; PG8_LDA(At, 0, 0); PG8_STA(PG8_SA(1, 1), a1, 1, offC);
            PG8_WAIT_V(8); PG8_WAIT_L(0); PG8_BAR; PG8_MMA(0, 0, At, B0); PG8_MMA(0, 1, At, B1); PG8_BAR; PG8_SCHED;
            PG8_LDA(At, 0, 1); PG8_STAGE(PG8_SB(0, 0), b2, voffB); PG8_STAGE(PG8_SB(0, 1), b2 + hstep, voffB); PG8_STA(PG8_SA(0, 0), a2, 0, o2);
            PG8_WAIT_V(8); PG8_WAIT_L(0); PG8_BAR; PG8_MMA(1, 0, At, B0); PG8_MMA(1, 1, At, B1); PG8_BAR; PG8_SCHED;
            PG8_LDB(B0, 1, 0); PG8_LDB(B1, 1, 1); PG8_SCHED; PG8_LDA(At, 1, 0); PG8_STA(PG8_SA(0, 1), a2, 1, o2);
            PG8_WAIT_V(8); PG8_WAIT_L(0); PG8_BAR; PG8_MMA(0, 0, At, B0); PG8_MMA(0, 1, At, B1); PG8_BAR; PG8_SCHED;
            PG8_LDA(At, 1, 1); PG8_STAGE(PG8_SB(1, 0), b3, voffB); PG8_STAGE(PG8_SB(1, 1), b3 + hstep, voffB); PG8_STA(PG8_SA(1, 0), a3, 0, o2);
            PG8_WAIT_V(8); PG8_WAIT_L(0); PG8_BAR; PG8_MMA(1, 0, At, B0); PG8_MMA(1, 1, At, B1); PG8_BAR; PG8_SCHED;
            } else {
            PG8_LDB(B0, 0, 0); PG8_SCHED; PG8_LDA(At, 0, 0); PG8_STAGE(PG8_SA(1, 1), a1 + hstep, voffA);
            PG8_WAIT_L(8); PG8_BAR; PG8_WAIT_L(0); PG8_MMA(0, 0, At, B0); PG8_BAR; PG8_SCHED;
            PG8_LDB(B1, 0, 1); PG8_STAGE(PG8_SB(0, 0), b2, voffB);
            PG8_BAR; PG8_WAIT_L(0); PG8_MMA(0, 1, At, B1); PG8_BAR;
            PG8_LDA(At, 0, 1); PG8_STAGE(PG8_SA(0, 0), a2, voffA);
            PG8_BAR; PG8_WAIT_L(0); PG8_MMA(1, 0, At, B0); PG8_BAR; PG8_SCHED;
            PG8_STAGE(PG8_SB(0, 1), b2 + hstep, voffB);
            PG8_WAIT_V(6); PG8_BAR; PG8_MMA(1, 1, At, B1); PG8_BAR;
            PG8_LDB(B0, 1, 0); PG8_SCHED; PG8_LDA(At, 1, 0); PG8_STAGE(PG8_SA(0, 1), a2 + hstep, voffA);
            PG8_WAIT_L(8); PG8_BAR; PG8_WAIT_L(0); PG8_MMA(0, 0, At, B0); PG8_BAR; PG8_SCHED;
            PG8_LDB(B1, 1, 1); PG8_STAGE(PG8_SB(1, 0), b3, voffB);
            PG8_BAR; PG8_WAIT_L(0); PG8_MMA(0, 1, At, B1); PG8_BAR;
            PG8_LDA(At, 1, 1); PG8_STAGE(PG8_SA(1, 0), a3, voffA);
            PG8_BAR; PG8_WAIT_L(0); PG8_MMA(1, 0, At, B0); PG8_BAR; PG8_SCHED;
            PG8_STAGE(PG8_SB(1, 1), b3 + hstep, voffB);
            PG8_WAIT_V(6); PG8_BAR; PG8_MMA(1, 1, At, B1); PG8_BAR;
            }
        }
        if constexpr (ALIGN_EPI) { if (wr == 0) PG8_BAR; }
        if constexpr (!Epi::AFTER_DRAIN) { E(acc, cur, wr, wc, fr, fq); S.done(cur); }
        if (!has_next) break;
#pragma unroll
        for (int a = 0; a < 2; ++a)
#pragma unroll
            for (int b = 0; b < 2; ++b)
#pragma unroll
                for (int m = 0; m < 4; ++m)
#pragma unroll
                    for (int n = 0; n < 2; ++n) acc[a][b][m][n] = (f32x4){0.f, 0.f, 0.f, 0.f};
        cur = nxt; cA = nA; cB = nB; ++ui;
        if constexpr (GATHER) {
#pragma unroll
            for (int h_ = 0; h_ < 2; ++h_)
#pragma unroll
                for (int i_ = 0; i_ < 2; ++i_) offC[h_][i_] = offN[h_][i_]; }
        if constexpr (ALIGN_EPI) { if (wr == 1) PG8_BAR; }
    }
    PG8_WAIT_V(0);
    if constexpr (!ALIGN_EPI) { if (wr == 0) PG8_BAR; }
    PG8_BAR;
    if constexpr (Epi::AFTER_DRAIN) { E.fused(acc, cur, wr, wc, fr, fq, lds, wid, lane); S.done(cur); }
#undef PG8_SA
#undef PG8_GOFF
#undef PG8_STA
#undef PG8_SB
#undef PG8_STAGE
#undef PG8_LDA
#undef PG8_LDB
#undef PG8_MMA
#undef PG8_WAIT_V
#undef PG8_WAIT_L
#undef PG8_BAR
#undef PG8_SCHED
}
}
#define XB_TMO      128
#define XB_XCNT(j)  (256  + 64 * (j))
#define XB_XSUB(j)  (1280 + 64 * (j))
#define XB_XGEN(j)  (2304 + 64 * (j))
#define XB_TOP      3328
#define XB_TOPGEN   3392
#define XCD_BAR_WORDS 3456
#define XB_SPIN_CAP (1u << 18)

__device__ __forceinline__ unsigned xb_ld(unsigned* p)              { return __hip_atomic_load(p, __ATOMIC_RELAXED, __HIP_MEMORY_SCOPE_AGENT); }
__device__ __forceinline__ unsigned xb_add(unsigned* p, unsigned v) { return __hip_atomic_fetch_add(p, v, __ATOMIC_RELAXED, __HIP_MEMORY_SCOPE_AGENT); }
__device__ __forceinline__ unsigned xb_xcc_id() { return (unsigned)__builtin_amdgcn_s_getreg((3 << 11) | 20) & 0xFu; }
#define XB_SPIN(cond, bar) do { unsigned _sp = 0; while (cond) { __builtin_amdgcn_s_sleep(1); \
    if ((++_sp & 255u) == 0u) { if (xb_ld(&(bar)[XB_TMO])) break; if (_sp > XB_SPIN_CAP) { atomicAdd(&(bar)[XB_TMO], 1u); break; } } } } while (0)

struct XcdBarrier {
    unsigned* bar; unsigned x;
    volatile LAS unsigned* st;
};

__device__ __forceinline__ XcdBarrier xcd_barrier_post(unsigned* bar, volatile LAS unsigned* st) {
    XcdBarrier b; b.bar = bar; b.x = xb_xcc_id(); b.st = st;
    if (threadIdx.x == 0) (void)xb_add(&bar[XB_XCNT(b.x)], 1u);
    return b;
}
__device__ __forceinline__ void xcd_barrier_complete(unsigned* bar, unsigned x, unsigned& nloc, unsigned& nx) {
    const unsigned G = gridDim.x * gridDim.y * gridDim.z;
    unsigned sum, cnt, mine, sp = 0u;
    for (;;) {
        sum = 0u; cnt = 0u; mine = 0u;
#pragma unroll
        for (unsigned j = 0; j < 16; ++j) { const unsigned c = xb_ld(&bar[XB_XCNT(j)]); sum += c; cnt += (c > 0u) ? 1u : 0u; mine = (j == x) ? c : mine; }
        if (sum == G) break;
        __builtin_amdgcn_s_sleep(1);
        if ((++sp & 255u) == 0u) { if (xb_ld(&bar[XB_TMO])) break; if (sp > XB_SPIN_CAP) { atomicAdd(&bar[XB_TMO], 1u); break; } }
    }
    nloc = mine > 0u ? mine : 1u; nx = cnt > 0u ? cnt : 1u;
}

__device__ __forceinline__ void xcd_barrier(const XcdBarrier& b) {
    asm volatile("s_waitcnt vmcnt(0)" ::: "memory");
    __syncthreads();
    if (threadIdx.x == 0) {
        unsigned* bar = b.bar;
        __builtin_amdgcn_s_waitcnt(0);
        unsigned nloc = b.st[0], nx = b.st[1];
        if (nloc == 0u) { xcd_barrier_complete(bar, b.x, nloc, nx); b.st[0] = nloc; b.st[1] = nx; }
        const unsigned old = xb_add(&bar[XB_XSUB(b.x)], 1u);
        const unsigned gen = old / nloc;
        if (old + 1u == (gen + 1u) * nloc) {
            __builtin_amdgcn_fence(__ATOMIC_RELEASE, "agent");
            asm volatile("s_waitcnt vmcnt(0)" ::: "memory");
            const unsigned og = xb_add(&bar[XB_TOP], 1u);
            const unsigned tg = og / nx;
            if (og + 1u == (tg + 1u) * nx) xb_add(&bar[XB_TOPGEN], 1u);
            else XB_SPIN(xb_ld(&bar[XB_TOPGEN]) == tg, bar);
            __builtin_amdgcn_fence(__ATOMIC_ACQUIRE, "agent");
            xb_add(&bar[XB_XGEN(b.x)], 1u);
            asm volatile("s_waitcnt vmcnt(0)" ::: "memory");
        } else {
            XB_SPIN(xb_ld(&bar[XB_XGEN(b.x)]) == gen, bar);
            __builtin_amdgcn_fence(__ATOMIC_ACQUIRE, "agent");
            asm volatile("s_waitcnt vmcnt(0)" ::: "memory");
        }
    }
    __syncthreads();
}
namespace pg8 {
struct EpiIn0 {
    static constexpr bool PERM = true, AFTER_DRAIN = false;
    bf16_t *Q, *K, *V, *Z, *XBC; float* DT; float qscale;
    __device__ __forceinline__ void operator()(const f32x4 (&acc)[2][2][4][2], const Unit& u, int wr, int wc, int fr, int fq) const {
        const int pn = u.pn, row0 = u.pm * BM + wr * 64 + fr;
        if (pn == 22) {
            if (wc == 0 && fq < 2) {
#pragma unroll
                for (int ai = 0; ai < 2; ++ai)
#pragma unroll
                    for (int m = 0; m < 4; ++m) { float* p = DT + (size_t)(row0 + ai * HALF + m * 16) * 16 + 8 * fq; *(f32x4*)p = acc[ai][0][m][0]; *(f32x4*)(p + 4) = acc[ai][0][m][1]; }
            }
            return;
        }
        bf16_t* base; int ld = 1024, colt; float sc = 1.f;
        if (pn < 4) { base = Q; colt = pn * BM; sc = qscale; } else if (pn < 8) { base = K; colt = (pn - 4) * BM; } else if (pn < 12) { base = V; colt = (pn - 8) * BM; }
        else if (pn < 16) { base = Z; colt = (pn - 12) * BM; } else { base = XBC; ld = 1536; colt = (pn - 16) * BM; }
        const int col0 = colt + wc * 32 + 8 * fq;
#pragma unroll
        for (int ai = 0; ai < 2; ++ai)
#pragma unroll
            for (int m = 0; m < 4; ++m) { bf16_t* rowp = base + (size_t)(row0 + ai * HALF + m * 16) * ld + col0;
#pragma unroll
                for (int bj = 0; bj < 2; ++bj) { const f32x4 v0 = acc[ai][bj][m][0] * sc, v1 = acc[ai][bj][m][1] * sc;
                    u32x4 w; w.x = cvt_pk_bf16(v0[0], v0[1]); w.y = cvt_pk_bf16(v0[2], v0[3]); w.z = cvt_pk_bf16(v1[0], v1[1]); w.w = cvt_pk_bf16(v1[2], v1[3]);
                    *(u32x4*)(rowp + bj * HALF) = w; } }
    }
};
struct EpiIn1 {
    static constexpr bool PERM = true, AFTER_DRAIN = false;
    bf16_t *Q, *KC, *VC, *KS, *VST, *KW, *VWT; float qscale;
    __device__ __forceinline__ void operator()(const f32x4 (&acc)[2][2][4][2], const Unit& u, int wr, int wc, int fr, int fq) const {
        const int pn = u.pn, row0 = u.pm * BM + wr * 64 + fr;
        if (pn < 8) {
            const int col0 = pn * BM + wc * 32 + 8 * fq;
#pragma unroll
            for (int ai = 0; ai < 2; ++ai)
#pragma unroll
                for (int m = 0; m < 4; ++m) { bf16_t* rowp = Q + (size_t)(row0 + ai * HALF + m * 16) * 2048 + col0;
#pragma unroll
                    for (int bj = 0; bj < 2; ++bj) { const f32x4 v0 = acc[ai][bj][m][0] * qscale, v1 = acc[ai][bj][m][1] * qscale;
                        u32x4 w; w.x = cvt_pk_bf16(v0[0], v0[1]); w.y = cvt_pk_bf16(v0[2], v0[3]); w.z = cvt_pk_bf16(v1[0], v1[1]); w.w = cvt_pk_bf16(v1[2], v1[3]);
                        *(u32x4*)(rowp + bj * HALF) = w; } }
            return;
        }
        const int idx = (pn - 8) >> 1, gp = (pn - 8) & 1, d0 = wc * 32 + 8 * fq;
        bf16_t* base = idx == 0 ? KC : idx == 1 ? VC : idx == 2 ? KS : idx == 3 ? VST : idx == 4 ? KW : VWT;
        const bool tr = (idx == 3 || idx == 5);
#pragma unroll
        for (int ai = 0; ai < 2; ++ai)
#pragma unroll
            for (int m = 0; m < 4; ++m) { const int row = row0 + ai * HALF + m * 16, b = row >> 13, s = row & 8191;
#pragma unroll
                for (int bj = 0; bj < 2; ++bj) { const int g = 2 * gp + bj; const f32x4 v0 = acc[ai][bj][m][0], v1 = acc[ai][bj][m][1];
                    if (!tr) { u32x4 w; w.x = cvt_pk_bf16(v0[0], v0[1]); w.y = cvt_pk_bf16(v0[2], v0[3]); w.z = cvt_pk_bf16(v1[0], v1[1]); w.w = cvt_pk_bf16(v1[2], v1[3]);
                        *(u32x4*)(base + ((size_t)(b * 4 + g) * 8192 + s) * 128 + d0) = w; }
                    else { bf16_t* p = base + ((size_t)(b * 4 + g) * 128 + d0) * 8192 + s;
                        p[0 * 8192] = (bf16_t)f2bf(v0[0]); p[1 * 8192] = (bf16_t)f2bf(v0[1]); p[2 * 8192] = (bf16_t)f2bf(v0[2]); p[3 * 8192] = (bf16_t)f2bf(v0[3]);
                        p[4 * 8192] = (bf16_t)f2bf(v1[0]); p[5 * 8192] = (bf16_t)f2bf(v1[1]); p[6 * 8192] = (bf16_t)f2bf(v1[2]); p[7 * 8192] = (bf16_t)f2bf(v1[3]); } } }
    }
};
struct EpiOut {
    static constexpr bool PERM = false, AFTER_DRAIN = false;
    const float* X; bf16_t* Y; float alpha;
    __device__ __forceinline__ void operator()(const f32x4 (&acc)[2][2][4][2], const Unit& u, int wr, int wc, int fr, int fq) const {
        const int row0 = u.pm * BM + wr * 64 + fr, col0 = u.pn * BM + wc * 32 + 4 * fq;
#pragma unroll
        for (int ai = 0; ai < 2; ++ai) { f32x4 xv[4][2][2];
#pragma unroll
            for (int m = 0; m < 4; ++m)
#pragma unroll
                for (int bj = 0; bj < 2; ++bj)
#pragma unroll
                    for (int n = 0; n < 2; ++n) xv[m][bj][n] = *(const f32x4*)(X + (size_t)(row0 + ai * HALF + m * 16) * 2048 + col0 + bj * HALF + n * 16);
#pragma unroll
            for (int m = 0; m < 4; ++m)
#pragma unroll
                for (int bj = 0; bj < 2; ++bj)
#pragma unroll
                    for (int n = 0; n < 2; ++n) { const f32x4 yv = xv[m][bj][n] * alpha + acc[ai][bj][m][n]; u32x2 w; w.x = cvt_pk_bf16(yv[0], yv[1]); w.y = cvt_pk_bf16(yv[2], yv[3]);
                        *(u32x2*)(Y + (size_t)(row0 + ai * HALF + m * 16) * 2048 + col0 + bj * HALF + n * 16) = w; } }
    }
};
struct EpiOutB {
    static constexpr bool PERM = false, AFTER_DRAIN = false;
    const bf16_t* X; bf16_t* Y; float alpha;
    __device__ __forceinline__ void operator()(const f32x4 (&acc)[2][2][4][2], const Unit& u, int wr, int wc, int fr, int fq) const {
        const int row0 = u.pm * BM + wr * 64 + fr, col0 = u.pn * BM + wc * 32 + 4 * fq;
#pragma unroll
        for (int ai = 0; ai < 2; ++ai) { u32x2 xv[4][2][2];
#pragma unroll
            for (int m = 0; m < 4; ++m)
#pragma unroll
                for (int bj = 0; bj < 2; ++bj)
#pragma unroll
                    for (int n = 0; n < 2; ++n) xv[m][bj][n] = *(const u32x2*)(X + (size_t)(row0 + ai * HALF + m * 16) * 2048 + col0 + bj * HALF + n * 16);
#pragma unroll
            for (int m = 0; m < 4; ++m)
#pragma unroll
                for (int bj = 0; bj < 2; ++bj)
#pragma unroll
                    for (int n = 0; n < 2; ++n) { const u32x2 x = xv[m][bj][n]; f32x4 xf; xf[0] = __uint_as_float(x.x << 16); xf[1] = __uint_as_float(x.x & 0xffff0000u); xf[2] = __uint_as_float(x.y << 16); xf[3] = __uint_as_float(x.y & 0xffff0000u);
                        const f32x4 yv = xf * alpha + acc[ai][bj][m][n]; u32x2 w; w.x = cvt_pk_bf16(yv[0], yv[1]); w.y = cvt_pk_bf16(yv[2], yv[3]);
                        *(u32x2*)(Y + (size_t)(row0 + ai * HALF + m * 16) * 2048 + col0 + bj * HALF + n * 16) = w; } }
    }
};
struct MoeOrder {
    const PG8_LAS int* tab; int G, c;
    __device__ __forceinline__ bool next(int i, Unit& u) const {
        const int n_mt = tab[0], x = c & 7, j = c >> 3, gidx = i * 8 + x, mt = gidx * 4 + (j >> 3), nt = j & 7;
        if (j >= 32 || mt >= n_mt) return false;
        u.pm = mt; u.pn = tab[64 + mt] * 8 + nt; return true;
    }
    __device__ __forceinline__ void a_ready(const Unit&) const {}
    __device__ __forceinline__ void done(const Unit&) const {}
};
struct EpiMoe1 {
    static constexpr bool PERM = true, AFTER_DRAIN = false;
    bf16_t* HID;
    __device__ __forceinline__ void operator()(const f32x4 (&acc)[2][2][4][2], const Unit& u, int wr, int wc, int fr, int fq) const {
        const int row0 = u.pm * BM + wr * 64 + fr, col0 = (u.pn & 7) * 128 + wc * 32 + 8 * fq;
#pragma unroll
        for (int ai = 0; ai < 2; ++ai)
#pragma unroll
            for (int m = 0; m < 4; ++m) { float h[8];
#pragma unroll
                for (int n = 0; n < 2; ++n)
#pragma unroll
                    for (int i = 0; i < 4; ++i) { const float g = acc[ai][0][m][n][i], up = acc[ai][1][m][n][i]; h[n * 4 + i] = g * __builtin_amdgcn_rcpf(1.f + __expf(-g)) * up; }
                u32x4 w; w.x = cvt_pk_bf16(h[0], h[1]); w.y = cvt_pk_bf16(h[2], h[3]); w.z = cvt_pk_bf16(h[4], h[5]); w.w = cvt_pk_bf16(h[6], h[7]);
                *(u32x4*)(HID + (size_t)(row0 + ai * HALF + m * 16) * 1024 + col0) = w; }
    }
};
struct EpiMoe2 {
    static constexpr bool PERM = true, AFTER_DRAIN = false;
    bf16_t* FOUT; const PG8_LAS int* rt; const PG8_LAS float* rw;
    __device__ __forceinline__ void operator()(const f32x4 (&acc)[2][2][4][2], const Unit& u, int wr, int wc, int fr, int fq) const {
        const int lr0 = (u.pm >> 5) * 256 + wr * 64 + fr, col0 = (u.pn & 7) * BM + wc * 32 + 8 * fq;
        int slots[2][4]; float gws[2][4];
#pragma unroll
        for (int ai = 0; ai < 2; ++ai)
#pragma unroll
            for (int m = 0; m < 4; ++m) { const int lr = lr0 + ai * HALF + m * 16; slots[ai][m] = rt[lr]; gws[ai][m] = rw[lr]; }
#pragma unroll
        for (int ai = 0; ai < 2; ++ai)
#pragma unroll
            for (int m = 0; m < 4; ++m) { const int slot = slots[ai][m]; const float gw = gws[ai][m];
                if (slot >= 0) { bf16_t* rowp = FOUT + (size_t)slot * 2048 + col0;
#pragma unroll
                    for (int bj = 0; bj < 2; ++bj) { const f32x4 v0 = acc[ai][bj][m][0] * gw, v1 = acc[ai][bj][m][1] * gw;
                        u32x4 w; w.x = cvt_pk_bf16(v0[0], v0[1]); w.y = cvt_pk_bf16(v0[2], v0[3]); w.z = cvt_pk_bf16(v1[0], v1[1]); w.w = cvt_pk_bf16(v1[2], v1[3]);
                        *(u32x4*)(rowp + bj * HALF) = w; } } }
    }
};
}

template <int NC, int KU, class AF, class BF>
__device__ __forceinline__ f32x16 small_gemm(LAS unsigned char* lds, int K, const AF& af, const BF& bfn, int tid) {
    constexpr int KS = 4 / NC, BKS = 64 * KS * KU, PITCH = BKS + 8, CPR = BKS / 8;
    constexpr int NA = 64 * CPR / NTHR, NB = 32 * NC * CPR / NTHR;
    static_assert(NA >= 1 && NB >= 1, "small_gemm geometry");
    LAS bf16* As = (LAS bf16*)lds;
    const int lane = tid & 63, wave = tid >> 6, wr = wave & 1, j = wave >> 1, wc = j % NC, kq = j / NC;
    typename AF::Raw ra0[NA], ra1[NA]; bf16x8 rb0[NB], rb1[NB];
    f32x16 acc;
#pragma unroll
    for (int i = 0; i < 16; ++i) acc[i] = 0.f;
    const int ns = K / BKS;
#define SG_LOAD(RA, RB, step) do { const int st_ = (step); \
        _Pragma("unroll") for (int i = 0; i < NA; ++i) { const int c = tid + NTHR * i; RA[i] = af.raw(c / CPR, st_ * CPR + c % CPR); } \
        _Pragma("unroll") for (int i = 0; i < NB; ++i) { const int c = tid + NTHR * i; RB[i] = bfn(c / CPR, st_ * CPR + c % CPR); } } while (0)
    constexpr int BUFE = (64 + 32 * NC) * PITCH;
#define SG_WRITE(RA, RB, cstep, b_) do { LAS bf16* Aw_ = As + (b_) * BUFE; LAS bf16* Bw_ = Aw_ + 64 * PITCH; const int cs_ = (cstep); \
        _Pragma("unroll") for (int i = 0; i < NA; ++i) { const int c = tid + NTHR * i; *(LAS bf16x8*)(Aw_ + (c / CPR) * PITCH + (c % CPR) * 8) = af.fin(RA[i], cs_ * CPR + c % CPR); } \
        _Pragma("unroll") for (int i = 0; i < NB; ++i) { const int c = tid + NTHR * i; *(LAS bf16x8*)(Bw_ + (c / CPR) * PITCH + (c % CPR) * 8) = RB[i]; } } while (0)
#define SG_MMA(b_) do { const LAS bf16* ap = As + (b_) * BUFE + (wr * 32 + (lane & 31)) * PITCH + kq * 64 * KU + 8 * (lane >> 5); \
          const LAS bf16* bp = As + (b_) * BUFE + 64 * PITCH + (wc * 32 + (lane & 31)) * PITCH + kq * 64 * KU + 8 * (lane >> 5); \
          _Pragma("unroll") for (int k0 = 0; k0 < 64 * KU; k0 += 64) {        \
            bf16x8 fa_[4], fb_[4]; \
            _Pragma("unroll") for (int k = 0; k < 4; ++k) { fa_[k] = *(const LAS bf16x8*)(ap + k0 + 16 * k); fb_[k] = *(const LAS bf16x8*)(bp + k0 + 16 * k); } \
            __builtin_amdgcn_sched_barrier(0); \
            _Pragma("unroll") for (int k = 0; k < 4; ++k) acc = __builtin_amdgcn_mfma_f32_32x32x16_bf16(fa_[k], fb_[k], acc, 0, 0, 0); } } while (0)
    SG_LOAD(ra0, rb0, 0); __builtin_amdgcn_sched_barrier(0); SG_LOAD(ra1, rb1, 1); __builtin_amdgcn_sched_barrier(0);
    SG_WRITE(ra0, rb0, 0, 0); SG_LOAD(ra0, rb0, min(2, ns - 1)); __builtin_amdgcn_sched_barrier(0);
    for (int s = 0; s < ns; s += 2) {
        __syncthreads(); SG_WRITE(ra1, rb1, min(s + 1, ns - 1), 1); SG_LOAD(ra1, rb1, min(s + 3, ns - 1)); SG_MMA(0);
        __syncthreads(); SG_WRITE(ra0, rb0, min(s + 2, ns - 1), 0); SG_LOAD(ra0, rb0, min(s + 4, ns - 1)); SG_MMA(1);
    }
    __syncthreads();
#undef SG_LOAD
#undef SG_WRITE
#undef SG_MMA
    return acc;
}
struct Args { const float* in[31]; float* out; unsigned char* wsbase; int ph_lo, ph_hi; };
struct Frame {
    LAS unsigned char* lds;
    volatile LAS unsigned* MISC;
    gu32* ctl;
    int tid, lane, wave, G, vcu;
    unsigned char* ws_;
};

__device__ __forceinline__ bool frame_refresh(Frame& F, unsigned char* ws_) { { const unsigned long long u_ = (unsigned long long)ws_; ws_ = (unsigned char*)((unsigned long long)(unsigned)__builtin_amdgcn_readfirstlane((unsigned)u_) | ((unsigned long long)(unsigned)__builtin_amdgcn_readfirstlane((unsigned)(u_ >> 32)) << 32)); }
    GAS unsigned char* wg_ = (GAS unsigned char*)ws_; asm volatile("" : "+s"(wg_)); ws_ = (unsigned char*)wg_; F.ws_ = ws_; F.ctl = (gu32*)(ws_ + WS_CTL); int t = threadIdx.x; asm volatile("" : "+v"(t)); F.tid = t; F.lane = t & 63; F.wave = __builtin_amdgcn_readfirstlane(t >> 6); return true; }

struct TrJob { const float* W; int ldw, src_col0, nvalid, nblk; bf16* WT; int ldt, koff, mode; };
typedef float f32x2_t __attribute__((ext_vector_type(2))); typedef __bf16 bf16x2_t __attribute__((ext_vector_type(2)));
__device__ __forceinline__ unsigned cvtpk(float lo, float hi) { const f32x2_t v = {lo, hi}; const bf16x2_t b = __builtin_convertvector(v, bf16x2_t); return __builtin_bit_cast(unsigned, b); }
constexpr int TR_SMALL_ITEMS = 32 * 92 + 32 * 32 + 32 * 80 + 32 * 2 + 32 * 32 + 3 * 32 + 64 * 2 + 64 * 2 + 4 + 4;
constexpr int TR_MOE_ITEMS = 2 * 32 * 1536;
__device__ __forceinline__ void tr_job(const Args& a, unsigned char* ws, int it, TrJob& J, int& item) {
    int r = it;
    J.src_col0 = 0; J.koff = 0; J.mode = 0;
    if (r >= TR_SMALL_ITEMS) {
        r -= TR_SMALL_ITEMS; const int le = r / 1536, w = r % 1536, which = w >> 9, l = le >> 5, e = le & 31; item = w & 511;
        if (which < 2) { J.W = (which == 0 ? a.in[28] : a.in[29]) + (size_t)le * 2048 * 1024; J.ldw = 1024; J.nvalid = 1024; J.nblk = 16;
            J.WT = (bf16*)(ws + WS_MOEB1 + (size_t)l * 256 * MiB) + (size_t)e * 2048 * 2048; J.ldt = 2048; J.mode = 1 + which; }
        else { J.W = a.in[30] + (size_t)le * 1024 * 2048; J.ldw = 2048; J.nvalid = 2048; J.nblk = 32;
            J.WT = (bf16*)(ws + WS_MOEB2 + (size_t)l * 128 * MiB) + (size_t)e * 2048 * 1024; J.ldt = 1024; }
        return;
    }
    if (r < 32 * 92) { J.W = a.in[3]; J.ldw = EVEN_IN; J.nvalid = EVEN_IN; J.nblk = 92; J.WT = (bf16*)(ws + WS_WIN0T); J.ldt = 2048; item = r; return; } r -= 32 * 92;
    if (r < 32 * 32) { J.W = a.in[4]; J.ldw = 2048; J.nvalid = 2048; J.nblk = 32; J.WT = (bf16*)(ws + WS_WOUT0T); J.ldt = 2048; item = r; return; } r -= 32 * 32;
    if (r < 32 * 80) { J.W = a.in[16]; J.ldw = ODD_IN; J.nvalid = ODD_MAIN; J.nblk = 80; J.WT = (bf16*)(ws + WS_WIN1T); J.ldt = 2048; item = r; return; } r -= 32 * 80;
    if (r < 32 * 2) { J.W = a.in[16]; J.ldw = ODD_IN; J.src_col0 = ODD_MAIN; J.nvalid = 48; J.nblk = 2; J.WT = (bf16*)(ws + WS_WGT); J.ldt = 2048; item = r; return; } r -= 32 * 2;
    if (r < 32 * 32) { J.W = a.in[17]; J.ldw = 2048; J.nvalid = 2048; J.nblk = 32; J.WT = (bf16*)(ws + WS_WOUT1T); J.ldt = 2048; item = r; return; } r -= 32 * 32;
    if (r < 96) { const int seg = r >> 5; J.W = a.in[1]; J.ldw = 32; J.nvalid = 32; J.nblk = 1; J.WT = (bf16*)(ws + WS_WRT3); J.ldt = 6144; J.koff = seg * 2048; J.mode = (seg == 1) ? 3 : 0; item = r & 31; return; } r -= 96;
    if (r < 128) { J.W = a.in[20]; J.ldw = 128; J.nvalid = 128; J.nblk = 2; J.WT = (bf16*)(ws + WS_W1KT); J.ldt = 4096; item = r; return; } r -= 128;
    if (r < 128) { J.W = a.in[22]; J.ldw = 128; J.nvalid = 128; J.nblk = 2; J.WT = (bf16*)(ws + WS_W1VT); J.ldt = 4096; item = r; return; } r -= 128;
    if (r < 4) { J.W = a.in[21]; J.ldw = 128; J.nvalid = 128; J.nblk = 2; J.WT = (bf16*)(ws + WS_W2KT); J.ldt = 128; item = r; return; } r -= 4;
    { J.W = a.in[23]; J.ldw = 128; J.nvalid = 128; J.nblk = 2; J.WT = (bf16*)(ws + WS_W2VT); J.ldt = 128; item = r; }
}
__device__ __forceinline__ void tr_load(const TrJob& J, int item, int lane, f32x4 (&v)[16]) {
    const int kb = item / J.nblk, nb = item % J.nblk, k0 = 64 * kb, n0 = 64 * nb, kp = lane >> 4, nc = lane & 15;
    const bool ok = (n0 + 4 * nc) < J.nvalid;
    const float* src = J.W + (size_t)(k0 + 2 * kp) * J.ldw + J.src_col0 + n0 + 4 * nc;
#pragma unroll
    for (int i = 0; i < 8; ++i) { v[2 * i] = ok ? *(const f32x4*)(src + (size_t)(8 * i) * J.ldw) : (f32x4){0.f, 0.f, 0.f, 0.f}; v[2 * i + 1] = ok ? *(const f32x4*)(src + (size_t)(8 * i + 1) * J.ldw) : (f32x4){0.f, 0.f, 0.f, 0.f}; }
}
__device__ __forceinline__ void tr_store(const TrJob& J, int item, int lane, const f32x4 (&v)[16], LAS unsigned* T) {
    const int kb = item / J.nblk, nb = item % J.nblk, k0 = 64 * kb, n0 = 64 * nb, kp = lane >> 4, nc = lane & 15;
#pragma unroll
    for (int i = 0; i < 8; ++i)
#pragma unroll
        for (int j = 0; j < 4; ++j) { float a = v[2 * i][j], b = v[2 * i + 1][j];
            if (J.mode == 3) { a = a - bf2f(f2bf(a)); b = b - bf2f(f2bf(b)); }
            T[(4 * nc + j) * 36 + 4 * i + kp] = cvtpk(a, b); }
    LDS_WAIT(); asm volatile("" ::: "memory");
#pragma unroll
    for (int p = 0; p < 8; ++p) { const int id = lane + 64 * p, n = id >> 3, c = id & 7; const u32x4 o = *(const LAS u32x4*)(T + n * 36 + 4 * c);
        const int nn = n0 + n; int row = nn;
        if (J.mode == 1) row = (nn >> 7) * 256 + (nn & 127); else if (J.mode == 2) row = (nn >> 7) * 256 + 128 + (nn & 127);
        *(u32x4*)(J.WT + (size_t)row * J.ldt + J.koff + k0 + 8 * c) = o; }
    LDS_WAIT(); asm volatile("" ::: "memory");
}
__device__ __forceinline__ void tr_run(Frame& F, const Args& a, const int it_begin, const int it_end) {
    const int lane = F.lane, wave = F.wave;
    LAS unsigned* T = (LAS unsigned*)(F.lds + wave * 16384);
    const int gw = F.vcu * NWAVES + wave, NGW = F.G * NWAVES;
    f32x4 cur[16], n1[16], n2[16]; TrJob Jc, J1, J2; int ic = 0, i1 = 0, i2 = 0;
    int it = it_begin + gw;
    if (it < it_end) { tr_job(a, F.ws_, it, Jc, ic); tr_load(Jc, ic, lane, cur); }
    if (it + NGW < it_end) { tr_job(a, F.ws_, it + NGW, J1, i1); tr_load(J1, i1, lane, n1); }
    while (it < it_end) {
        const int it2 = it + 2 * NGW;
        if (it2 < it_end) { tr_job(a, F.ws_, it2, J2, i2); tr_load(J2, i2, lane, n2); }
        tr_store(Jc, ic, lane, cur, T);
#pragma unroll
        for (int i = 0; i < 16; ++i) { cur[i] = n1[i]; n1[i] = n2[i]; }
        Jc = J1; ic = i1; J1 = J2; i1 = i2;
        it += NGW;
    }
}
constexpr int TR_MOE_LAYER_ITEMS = 32 * 1536;
__device__ __forceinline__ void tr_moe_slice(Frame& F, const Args& a, int l, int s, int ns) {
    const int per = TR_MOE_LAYER_ITEMS / ns, base = TR_SMALL_ITEMS + l * TR_MOE_LAYER_ITEMS + s * per;
    tr_run(F, a, base, base + per);
}
struct MoeItem { const char* sb; char* db; int down; };
__device__ __forceinline__ MoeItem moe_item2(const Args& a, unsigned char* ws, int layer, int sidx, int it);
__device__ __forceinline__ MoeItem moe_item(const Args& a, unsigned char* ws, int layer, int q, int gw) { return moe_item2(a, ws, layer, gw + 2048 * (q >> 2), q & 3); }
__device__ __forceinline__ MoeItem moe_item2(const Args& a, unsigned char* ws, int layer, int sidx, int it) {
    const int e = sidx / 384, r = sidx % 384, le = layer * 32 + e; MoeItem M;
    if (r < 256) { const int which = r >> 7, rr = r & 127, kb = rr >> 2, nq = rr & 3;
        const float* W = (which ? a.in[29] : a.in[28]) + (size_t)le * 2048 * 1024;
        M.sb = (const char*)(W + (size_t)(64 * kb) * 1024 + nq * 256 + it * 64);
        bf16* D = (bf16*)(ws + WS_MOEB1 + (size_t)layer * 256 * MiB) + (size_t)e * 2048 * 2048;
        M.db = (char*)(D + (size_t)((nq * 2 + (it >> 1)) * 256 + which * 128 + 64 * (it & 1)) * 2048 + 64 * kb); M.down = 0; }
    else { const int rr = r - 256, kb = rr >> 3, nq = rr & 7;
        const float* W = a.in[30] + (size_t)le * 1024 * 2048;
        M.sb = (const char*)(W + (size_t)(64 * kb) * 2048 + nq * 256 + it * 64);
        bf16* D = (bf16*)(ws + WS_MOEB2 + (size_t)layer * 128 * MiB) + (size_t)e * 2048 * 1024;
        M.db = (char*)(D + (size_t)(nq * 256 + it * 64) * 1024 + 64 * kb); M.down = 1; }
    return M;
}
template <int LDW> __device__ __forceinline__ void moe_ld(const char* sb, unsigned loff, f32x4 (&v)[16]) {
#pragma unroll
    for (int i = 0; i < 8; ++i) { v[2 * i] = __builtin_nontemporal_load((const f32x4*)(sb + (size_t)(8 * i) * LDW * 4 + loff)); v[2 * i + 1] = __builtin_nontemporal_load((const f32x4*)(sb + (size_t)(8 * i + 1) * LDW * 4 + loff)); }
}
template <int LDT> __device__ __forceinline__ void moe_st(const f32x4 (&v)[16], LAS unsigned* T, unsigned tw, unsigned trd, char* db, unsigned doff) {
#pragma unroll
    for (int i = 0; i < 8; ++i)
#pragma unroll
        for (int j = 0; j < 4; ++j) T[tw + j * 36 + 4 * i] = cvtpk(v[2 * i][j], v[2 * i + 1][j]);
    LDS_WAIT(); asm volatile("" ::: "memory");
#pragma unroll
    for (int p = 0; p < 8; ++p) { const u32x4 o = *(const LAS u32x4*)(T + trd + p * 8 * 36); __builtin_nontemporal_store(o, (u32x4*)(db + (size_t)p * 8 * LDT * 2 + doff)); }
    LDS_WAIT(); asm volatile("" ::: "memory");
}
__device__ __forceinline__ void tr_moe_layer(Frame& F, const Args& a, int layer) {
    int tid = threadIdx.x; asm volatile("" : "+v"(tid)); const int lane = tid & 63, wave = __builtin_amdgcn_readfirstlane(tid >> 6);
    LAS unsigned* T = (LAS unsigned*)(F.lds + wave * 16384);
    const int gw = F.vcu * NWAVES + wave, kp = lane >> 4, nc = lane & 15;
    const unsigned loffA = (unsigned)((2 * kp) * 1024 + 4 * nc) * 4u, loffB = (unsigned)((2 * kp) * 2048 + 4 * nc) * 4u;
    const unsigned doffA = (unsigned)((lane >> 3) * 2048 + 8 * (lane & 7)) * 2u, doffB = (unsigned)((lane >> 3) * 1024 + 8 * (lane & 7)) * 2u;
    const unsigned tw = (unsigned)(4 * nc) * 36u + (unsigned)kp, trd = (unsigned)(lane >> 3) * 36u + 4u * (unsigned)(lane & 7);
    const int sbase = F.vcu * 48 + (wave >> 2), itw = wave & 3;
    f32x4 cur[16], n1[16], n2[16]; MoeItem Mc, M1, M2;
    Mc = moe_item2(a, F.ws_, layer, sbase, itw); if (Mc.down) moe_ld<2048>(Mc.sb, loffB, cur); else moe_ld<1024>(Mc.sb, loffA, cur);
    M1 = moe_item2(a, F.ws_, layer, sbase + 2, itw); if (M1.down) moe_ld<2048>(M1.sb, loffB, n1); else moe_ld<1024>(M1.sb, loffA, n1);
    for (int q = 0; q < 24; ++q) {
        if (q + 2 < 24) { M2 = moe_item2(a, F.ws_, layer, sbase + 2 * (q + 2), itw); if (M2.down) moe_ld<2048>(M2.sb, loffB, n2); else moe_ld<1024>(M2.sb, loffA, n2); }
        if (Mc.down) moe_st<1024>(cur, T, tw, trd, Mc.db, doffB); else moe_st<2048>(cur, T, tw, trd, Mc.db, doffA);
#pragma unroll
        for (int i = 0; i < 16; ++i) { cur[i] = n1[i]; n1[i] = n2[i]; }
        Mc = M1; M1 = M2;
    }
}
__device__ __forceinline__ void phase_prologue(Frame& F, const Args& a) {
    tr_run(F, a, 0, TR_SMALL_ITEMS);
#if !MOE_CVT_IN_ATTN
    tr_run(F, a, TR_SMALL_ITEMS, TR_SMALL_ITEMS + TR_MOE_ITEMS);
#endif
    const f32x4* x4 = (const f32x4*)a.in[0]; u32x2* xb = (u32x2*)(F.ws_ + WS_XB);
    const size_t T_ = (size_t)F.G * NTHR, N4_ = (size_t)NTOK * DM / 4; size_t i = (size_t)blockIdx.x * NTHR + F.tid;
    for (; i + 15 * T_ < N4_; i += 16 * T_) { f32x4 v[16];
#pragma unroll
        for (int k = 0; k < 16; ++k) v[k] = __builtin_nontemporal_load(x4 + i + k * T_);
#pragma unroll
        for (int k = 0; k < 16; ++k) { u32x2 o; o.x = cvtpk(v[k].x, v[k].y); o.y = cvtpk(v[k].z, v[k].w); xb[i + k * T_] = o; } }
    for (; i < N4_; i += T_) { const f32x4 v = x4[i]; u32x2 o; o.x = cvtpk(v.x, v.y); o.y = cvtpk(v.z, v.w); xb[i] = o; }
}

__device__ __forceinline__ void ln_stats(f32x4 (&v)[8], float& mean, float& rstd) {
    float s = 0.f;
#pragma unroll
    for (int j = 0; j < 8; ++j) s += (v[j].x + v[j].y) + (v[j].z + v[j].w);
    mean = wave_sum(s) * (1.f / DM); float s2 = 0.f;
#pragma unroll
    for (int j = 0; j < 8; ++j) { v[j] = v[j] - mean; s2 += (v[j].x * v[j].x + v[j].y * v[j].y) + (v[j].z * v[j].z + v[j].w * v[j].w); }
    rstd = 1.f / sqrtf(wave_sum(s2) * (1.f / DM) + LN_EPS);
}

struct RouterA { const bf16* hb; const bf16* hlo; int r0; typedef bf16x8 Raw;
    __device__ __forceinline__ bf16x8 raw(int r, int kc) const { const int seg = kc >> 8; const bf16* p = hb + (size_t)(r0 + r) * DM + (kc & 255) * 8; (void)seg; return *(const bf16x8*)p; }
    __device__ __forceinline__ bf16x8 fin(bf16x8 x, int) const { return x; } };
struct RouterB { const bf16* w;
    __device__ __forceinline__ bf16x8 operator()(int r, int kc) const { return *(const bf16x8*)(w + (size_t)r * 6144 + kc * 8); } };
__device__ __forceinline__ void phase_ln1_router(Frame& F, const Args& a, int layer) {
    unsigned char* ws = F.ws_; const bf16* RB = (const bf16*)(ws + WS_R); bf16* HB = (bf16*)(ws + WS_HB); bf16* HLO = (bf16*)(ws + WS_HLO);
    const float* g = a.in[24] + layer * DM; const float* bta = a.in[25] + layer * DM; const float* rbias = a.in[2];
    int* tok_e = (int*)(ws + WS_TOK); int* tok_pos = tok_e + 32768; float* tok_w = (float*)(tok_pos + 32768);
    gu32* cnt = F.ctl + CW_CNT + 64 * layer;
    f32x4 gv[8], bv[8];
#pragma unroll
    for (int j = 0; j < 8; ++j) { gv[j] = ((const f32x4*)g)[F.lane + 64 * j]; bv[j] = ((const f32x4*)bta)[F.lane + 64 * j]; }
    for (int u = blockIdx.x; u < NTOK / 64; u += F.G) {
        const int r0 = u * 64;
#define LN1_LOAD(V, i_) do { const u32x2* y_ = (const u32x2*)(RB + (size_t)(r0 + F.wave + 8 * (i_)) * DM) + F.lane; \
            _Pragma("unroll") for (int j = 0; j < 8; ++j) V##r[j] = y_[64 * j]; } while (0)
#define LN1_DO(V, i_) do { const int row = r0 + F.wave + 8 * (i_); f32x4 V[8]; \
            _Pragma("unroll") for (int j = 0; j < 8; ++j) { const u32x2 w_ = V##r[j]; V[j].x = bflo(w_.x); V[j].y = bfhi(w_.x); V[j].z = bflo(w_.y); V[j].w = bfhi(w_.y); } \
            float mean, rstd; ln_stats(V, mean, rstd); \
            u32x2* hb = (u32x2*)(HB + (size_t)row * DM) + F.lane; \
            _Pragma("unroll") for (int j = 0; j < 8; ++j) { const f32x4 h = V[j] * rstd * gv[j] + bv[j]; \
                u32x2 o; o.x = cvtpk(h.x, h.y); o.y = cvtpk(h.z, h.w); hb[64 * j] = o; } } while (0)
        { u32x2 par[8], pbr[8], pcr[8];
          LN1_LOAD(pa, 0); LN1_LOAD(pb, 1); LN1_LOAD(pc, 2); LN1_DO(pa, 0); LN1_LOAD(pa, 3); LN1_DO(pb, 1); LN1_LOAD(pb, 4); LN1_DO(pc, 2); LN1_LOAD(pc, 5);
          LN1_DO(pa, 3); LN1_LOAD(pa, 6); LN1_DO(pb, 4); LN1_LOAD(pb, 7); LN1_DO(pc, 5); LN1_DO(pa, 6); LN1_DO(pb, 7); }
#undef LN1_LOAD
#undef LN1_DO
        VM_WAIT(); __syncthreads();
        RouterA af{HB, HLO, r0}; RouterB bfn{(const bf16*)(ws + WS_WRT3)};
        const f32x16 acc = small_gemm<1, 1>(F.lds, 4096, af, bfn, F.tid);
        LAS float* red = (LAS float*)(F.lds);
        { const int wr = F.wave & 1, kq = F.wave >> 1, hi = F.lane >> 5, col = F.lane & 31;
#pragma unroll
          for (int r = 0; r < 16; ++r) red[(kq * 64 + wr * 32 + crow(r, hi)) * 33 + col] = acc[r]; }
        __syncthreads();
        if (F.tid < 64) {
            const int t = r0 + F.tid; const LAS float* lr = red + F.tid * 33;
            float best = -1e30f; int be1 = 0, be2 = 0; float bw1 = 0.f, bw2 = 0.f;
            for (int gq = 0; gq < 8; ++gq) {
                float t1v = -1e30f, t2v = -1e30f, t1s = 0.f, t2s = 0.f; int t1i = 0, t2i = 0;
#pragma unroll
                for (int i = 0; i < 4; ++i) { const int e = gq * 4 + i; const float lg = lr[e] + lr[64 * 33 + e] + lr[128 * 33 + e] + lr[192 * 33 + e];
                    const float s = 1.f / (1.f + expf(-lg)), bv = s + rbias[e];
                    if (bv > t1v) { t2v = t1v; t2i = t1i; t2s = t1s; t1v = bv; t1i = e; t1s = s; } else if (bv > t2v) { t2v = bv; t2i = e; t2s = s; } }
                const float gs = t1v + t2v;
                if (gs > best) { best = gs; be1 = t1i; be2 = t2i; bw1 = t1s; bw2 = t2s; }
            }
            const float inv = 1.f / (bw1 + bw2);
            const int p1 = (int)__hip_atomic_fetch_add(cnt + be1, 1u, RLX_AGENT), p2 = (int)__hip_atomic_fetch_add(cnt + be2, 1u, RLX_AGENT);
            tok_e[2 * t] = be1; tok_e[2 * t + 1] = be2; tok_pos[2 * t] = p1; tok_pos[2 * t + 1] = p2; tok_w[2 * t] = bw1 * inv; tok_w[2 * t + 1] = bw2 * inv;
        }
        __syncthreads();
    }
}

__device__ __forceinline__ void moe_tables(Frame& F, int layer) {
    LAS int* tab = (LAS int*)(F.lds + MOE_TAB_OFF);
    if (F.tid < 64) {
        const int e = F.lane; int c = 0; if (e < NEXP) c = (int)__hip_atomic_load(F.ctl + CW_CNT + 64 * layer + e, RLX_AGENT);
        const int tiles = (c + 255) >> 8; int incl = tiles;
#pragma unroll
        for (int d = 1; d < 32; d <<= 1) { const int v = __shfl_up(incl, d); if (e >= d) incl += v; }
        const int excl = incl - tiles;
        if (e < NEXP) { tab[1 + e] = excl * 256; for (int i = 0; i < tiles; ++i) tab[64 + excl + i] = e; }
        if (e == NEXP - 1) { tab[33] = incl * 256; tab[0] = incl; } }
    __syncthreads();
}
constexpr int GTAB_OFF = LDSCTL_OFF + 2048;
template <class Sched> __device__ __forceinline__ void moe_gather_table(Frame& F, const Sched& S, const int* rowtok) {
    LAS unsigned* gtab = (LAS unsigned*)(F.lds + GTAB_OFF);
    int sl[8];
#pragma unroll
    for (int i = 0; i < 8; ++i) { pg8::Unit u; const bool ok = S.next(i, u); sl[i] = (ok && F.tid < 256) ? rowtok[u.pm * 256 + F.tid] : -2; }
#pragma unroll
    for (int i = 0; i < 8; ++i) if (sl[i] != -2) gtab[i * 256 + F.tid] = (unsigned)(sl[i] >= 0 ? (sl[i] >> 1) : 0) * (unsigned)(DM * 2);
    __syncthreads();
}
constexpr int RT_OFF = GTAB_OFF, RW_OFF = GTAB_OFF + 5 * 1024;
template <class Sched> __device__ __forceinline__ void moe_rowmap_table(Frame& F, const Sched& S, const int* rowtok, const float* roww) {
    LAS int* rt = (LAS int*)(F.lds + RT_OFF); LAS float* rw = (LAS float*)(F.lds + RW_OFF);
    int sl[5]; float gw[5]; bool okv[5];
#pragma unroll
    for (int i = 0; i < 5; ++i) { pg8::Unit u; okv[i] = S.next(i, u) && F.tid < 256; sl[i] = okv[i] ? rowtok[u.pm * 256 + F.tid] : -1; gw[i] = okv[i] ? roww[u.pm * 256 + F.tid] : 0.f; }
#pragma unroll
    for (int i = 0; i < 5; ++i) if (okv[i]) { rt[i * 256 + F.tid] = sl[i]; rw[i * 256 + F.tid] = gw[i]; }
    __syncthreads();
}
__device__ __forceinline__ void phase_permute(Frame& F, const Args& a, int layer) {
    unsigned char* ws = F.ws_; moe_tables(F, layer);
    const LAS int* tab = (const LAS int*)(F.lds + MOE_TAB_OFF);
    const int* tok_e = (const int*)(ws + WS_TOK); const int* tok_pos = tok_e + 32768; const float* tok_w = (const float*)(tok_pos + 32768);
    int* rowtok = (int*)(ws + WS_TOK + 3 * 131072); float* roww = (float*)(rowtok + XG_ROWS);
    const bf16* HB = (const bf16*)(ws + WS_HB); bf16* XG = (bf16*)(ws + WS_XG);
    const int gw = blockIdx.x * NWAVES + F.wave, NGW = F.G * NWAVES;
#if MOE_GATHER
    for (int slot = blockIdx.x * NTHR + F.tid; slot < 2 * NTOK; slot += F.G * NTHR) { const int row = tab[1 + tok_e[slot]] + tok_pos[slot]; rowtok[row] = slot; roww[row] = tok_w[slot]; }
    if (0)
#endif
    for (int slot = gw; slot < 2 * NTOK; slot += NGW) {
        const int e = tok_e[slot], row = tab[1 + e] + tok_pos[slot];
        if (F.lane == 0) { rowtok[row] = slot; roww[row] = tok_w[slot]; }
#if !MOE_GATHER
        const u32x4* src = (const u32x4*)(HB + (size_t)(slot >> 1) * DM) + F.lane; u32x4* dst = (u32x4*)(XG + (size_t)row * DM) + F.lane;
#pragma unroll
        for (int j = 0; j < 4; ++j) dst[64 * j] = src[64 * j];
#endif
    }
    if (blockIdx.x < NEXP) { const int e = blockIdx.x, c = (int)__hip_atomic_load(F.ctl + CW_CNT + 64 * layer + e, RLX_AGENT), lo = tab[1 + e] + c, hi = tab[2 + e];
        for (int r = lo + F.tid; r < hi; r += NTHR) { rowtok[r] = -1; roww[r] = 0.f; } }
}
__device__ __forceinline__ void phase_ln2(Frame& F, const Args& a, int layer) {
    unsigned char* ws = F.ws_; const bf16* HB = (const bf16*)(ws + WS_HB); const bf16* HLO = (const bf16*)(ws + WS_HLO); const bf16* FO = (const bf16*)(ws + WS_FOUT); bf16* XB = (bf16*)(ws + WS_XB);
    const float* g = a.in[26] + layer * DM; const float* bta = a.in[27] + layer * DM;
    const int gw = blockIdx.x * NWAVES + F.wave, NGW = F.G * NWAVES;
    f32x4 gv[8], bv[8];
#pragma unroll
    for (int j = 0; j < 8; ++j) { gv[j] = ((const f32x4*)g)[F.lane + 64 * j]; bv[j] = ((const f32x4*)bta)[F.lane + 64 * j]; }
#define LN2_LOAD(S_, row_) do { const int r_ = (row_); const u32x2* hh_ = (const u32x2*)(HB + (size_t)r_ * DM) + F.lane; \
        const u32x2* f0_ = (const u32x2*)(FO + (size_t)(2 * r_) * DM) + F.lane; const u32x2* f1_ = f0_ + DM / 4; \
        _Pragma("unroll") for (int j = 0; j < 8; ++j) { S_[0][j] = hh_[64 * j]; S_[2][j] = f0_[64 * j]; S_[3][j] = f1_[64 * j]; } } while (0)
#define LN2_DO(S_, row_) do { const int r_ = (row_); f32x4 v[8]; \
        _Pragma("unroll") for (int j = 0; j < 8; ++j) { const u32x2 hx = S_[0][j], p = S_[2][j], q = S_[3][j]; f32x4 h; h.x = bflo(hx.x); h.y = bfhi(hx.x); h.z = bflo(hx.y); h.w = bfhi(hx.y); \
            v[j].x = ALPHA * h.x + (bflo(p.x) + bflo(q.x)); v[j].y = ALPHA * h.y + (bfhi(p.x) + bfhi(q.x)); v[j].z = ALPHA * h.z + (bflo(p.y) + bflo(q.y)); v[j].w = ALPHA * h.w + (bfhi(p.y) + bfhi(q.y)); } \
        float mean, rstd; ln_stats(v, mean, rstd); \
        f32x4* outr = (f32x4*)(a.out + (size_t)r_ * DM) + F.lane; u32x2* xb = (u32x2*)(XB + (size_t)r_ * DM) + F.lane; \
        _Pragma("unroll") for (int j = 0; j < 8; ++j) { const f32x4 o = v[j] * rstd * gv[j] + bv[j]; \
            if (layer == 1) outr[64 * j] = o; else { u32x2 w; w.x = cvtpk(o.x, o.y); w.y = cvtpk(o.z, o.w); xb[64 * j] = w; } } } while (0)
    u32x2 sa[4][8], sb[4][8];
    const int nrows = NTOK / NGW; int k = 0;
    LN2_LOAD(sa, gw);
    for (; k + 2 < nrows; k += 2) { LN2_LOAD(sb, gw + (k + 1) * NGW); LN2_DO(sa, gw + k * NGW); LN2_LOAD(sa, gw + (k + 2) * NGW); LN2_DO(sb, gw + (k + 1) * NGW); }
    LN2_LOAD(sb, gw + (k + 1) * NGW); LN2_DO(sa, gw + k * NGW); LN2_DO(sb, gw + (k + 1) * NGW);
#undef LN2_LOAD
#undef LN2_DO
}
namespace attn_body {
using bf16x8=__attribute__((ext_vector_type(8)))short;
using s16x4=__attribute__((ext_vector_type(4)))short;
using f32x16=__attribute__((ext_vector_type(16)))float;
using u32x4=__attribute__((ext_vector_type(4)))unsigned;
constexpr int BATCH=2,NHEAD=16,SEQ=8192,D=64,DM=NHEAD*D;
constexpr int NW=8,QBLK=32,QB=QBLK*NW,KVBLK=64,NQB=SEQ/QB;
constexpr int ATTN_PITCH=DM, ATTN_UNIT_ROWS=QB;
__device__ __forceinline__ int crow(int r,int hi){return (r&3)+8*(r>>2)+4*hi;}
#define SBAR() __builtin_amdgcn_sched_barrier(0)
__device__ __forceinline__ void cmask(f32x16&p0,f32x16&p1,int jb,int qrel,int hi){
  const float NEG=-INFINITY; int kb=64*jb+4*hi;
  #pragma unroll
  for(int r=0;r<16;++r){int kv=kb+(r&3)+8*(r>>2); if(kv>qrel)p0[r]=NEG; if(kv+32>qrel)p1[r]=NEG;}
}

constexpr int NSLOT=3, SLOTB=8192;
constexpr int LDS_K=0, LDS_V=NSLOT*SLOTB, LDS_WS=2*NSLOT*SLOTB, LDS_OST=LDS_WS+NW*64*4, LDS_BYTES=LDS_OST+NW*4096;
constexpr float C2=0.125f*1.4426950408889634f;
__device__ __forceinline__ void glds16(const void*gsrc,unsigned lds_dst){unsigned keep;
  asm volatile("s_mov_b32 %0, m0\n\ts_mov_b32 m0, %2\n\ts_nop 0\n\tglobal_load_lds_dwordx4 %1, off\n\ts_mov_b32 m0, %0":"=&s"(keep):"v"(gsrc),"s"(lds_dst):"memory");}
__device__ __forceinline__ float max3f(float a,float b,float c){float r;asm("v_max3_f32 %0, %1, %2, %3":"=v"(r):"v"(a),"v"(b),"v"(c));return r;}
__device__ __forceinline__ float max2f(float a,float b){float r;asm("v_max_f32_e32 %0, %1, %2":"=v"(r):"v"(a),"v"(b));return r;}
__device__ __forceinline__ float fadd_s(float a,float b){float r;asm("v_add_f32_e32 %0, %1, %2":"=v"(r):"v"(a),"v"(b));return r;}
__device__ __forceinline__ float fsub_s(float a,float b){float r;asm("v_sub_f32_e32 %0, %1, %2":"=v"(r):"v"(a),"v"(b));return r;}
typedef float f32x2_t __attribute__((ext_vector_type(2))); typedef __bf16 bf16x2_t __attribute__((ext_vector_type(2)));
__device__ __forceinline__ unsigned cvtpk_s(float lo,float hi){f32x2_t v={lo,hi};bf16x2_t b=__builtin_convertvector(v,bf16x2_t);return __builtin_bit_cast(unsigned,b);}
#define WAIT_BAR(N) asm volatile("s_waitcnt vmcnt(" #N ") lgkmcnt(0)\n\ts_barrier":::"memory")

__device__ __forceinline__ void qkt(f32x16&p0,f32x16&p1,const char*Kslot,const bf16x8*qr,const f32x16&negm,int r32,int hi){
  const char*kb=Kslot+hi*1024+r32*16;
  #pragma unroll
  for(int d0=0;d0<4;++d0){
    const bf16x8 b0=*reinterpret_cast<const bf16x8*>(kb+d0*2048);
    const bf16x8 b1=*reinterpret_cast<const bf16x8*>(kb+d0*2048+512);
    if(d0==0){p0=__builtin_amdgcn_mfma_f32_32x32x16_bf16(b0,qr[0],negm,0,0,0);p1=__builtin_amdgcn_mfma_f32_32x32x16_bf16(b1,qr[0],negm,0,0,0);}
    else{p0=__builtin_amdgcn_mfma_f32_32x32x16_bf16(b0,qr[d0],p0,0,0,0);p1=__builtin_amdgcn_mfma_f32_32x32x16_bf16(b1,qr[d0],p1,0,0,0);}}
}
typedef __attribute__((address_space(3))) const char* lds_cptr;
typedef short v4i16_t __attribute__((ext_vector_type(4)));
__device__ __forceinline__ void kload8(bf16x8*kf,lds_cptr kp){
  kf[0]=*(const __attribute__((address_space(3))) bf16x8*)(kp);      kf[1]=*(const __attribute__((address_space(3))) bf16x8*)(kp+512);
  kf[2]=*(const __attribute__((address_space(3))) bf16x8*)(kp+2048); kf[3]=*(const __attribute__((address_space(3))) bf16x8*)(kp+2560);
  kf[4]=*(const __attribute__((address_space(3))) bf16x8*)(kp+4096); kf[5]=*(const __attribute__((address_space(3))) bf16x8*)(kp+4608);
  kf[6]=*(const __attribute__((address_space(3))) bf16x8*)(kp+6144); kf[7]=*(const __attribute__((address_space(3))) bf16x8*)(kp+6656);
}
__device__ __forceinline__ void kload2(bf16x8*kf,lds_cptr kp,int j){ kf[2*j]=*(const __attribute__((address_space(3))) bf16x8*)(kp+j*2048); kf[2*j+1]=*(const __attribute__((address_space(3))) bf16x8*)(kp+j*2048+512); }
__device__ __forceinline__ s16x4 vtr(lds_cptr p){ return __builtin_bit_cast(s16x4,__builtin_amdgcn_ds_read_tr16_b64_v4i16((__attribute__((address_space(3))) v4i16_t*)p)); }
__device__ __forceinline__ float rowmax(const f32x16&p0,const f32x16&p1){
  float a=max3f(p0[0],p0[1],p1[0]),b=max3f(p0[2],p0[3],p1[1]);a=max3f(a,p1[2],p1[3]);
  #pragma unroll
  for(int r=4;r<16;r+=4){a=max3f(a,p0[r],p0[r+1]);b=max3f(b,p0[r+2],p0[r+3]);a=max3f(a,p1[r],p1[r+1]);b=max3f(b,p1[r+2],p1[r+3]);}
  const float m=max2f(a,b);
  auto rr=__builtin_amdgcn_permlane32_swap(__float_as_uint(m),__float_as_uint(m),false,false);
  return max2f(__uint_as_float(rr[0]),__uint_as_float(rr[1]));
}
__device__ __forceinline__ void pv(f32x16*o,int vb,bf16x8 pa0,bf16x8 pa1,bf16x8 pa2,bf16x8 pa3){
  #pragma unroll
  for(int d0=0;d0<2;++d0){s16x4 lo[4],hi[4];
    #pragma unroll
    for(int ks=0;ks<4;++ks){
      asm volatile("ds_read_b64_tr_b16 %0,%1 offset:%c2":"=&v"(lo[ks]):"v"(vb),"i"(d0*4096+ks*1024):"memory");
      asm volatile("ds_read_b64_tr_b16 %0,%1 offset:%c2":"=&v"(hi[ks]):"v"(vb),"i"(d0*4096+ks*1024+512):"memory");}
    asm volatile("s_waitcnt lgkmcnt(0)":::"memory");SBAR();
    #define PK(k) (bf16x8){lo[k][0],lo[k][1],lo[k][2],lo[k][3],hi[k][0],hi[k][1],hi[k][2],hi[k][3]}
    o[d0]=__builtin_amdgcn_mfma_f32_32x32x16_bf16(pa0,PK(0),o[d0],0,0,0);
    o[d0]=__builtin_amdgcn_mfma_f32_32x32x16_bf16(pa1,PK(1),o[d0],0,0,0);
    o[d0]=__builtin_amdgcn_mfma_f32_32x32x16_bf16(pa2,PK(2),o[d0],0,0,0);
    o[d0]=__builtin_amdgcn_mfma_f32_32x32x16_bf16(pa3,PK(3),o[d0],0,0,0);
    #undef PK
  }
}

#ifndef ATTN_STORE16
#define ATTN_STORE16(p,v) (*(u32x4*)(p)=(v))
#endif
template<int THRL> __device__ __forceinline__ void attn_unit(int b,int hq,int hv,int ho,int qb,const bf16*Q,const bf16*__restrict__ K,const bf16*__restrict__ V,bf16*O,char*shm){
  int tid_=threadIdx.x; asm volatile("":"+v"(tid_)); const int tid=tid_,lane=tid&63,r32=lane&31,hi=lane>>5; const int wid=__builtin_amdgcn_readfirstlane(tid>>6);
  const long rowbase=(long)b*SEQ; const int q0=qb*QB;
  const bf16*Qw=Q+(rowbase+q0+wid*QBLK)*DM+hq*D;
  const bf16*Kh=K+rowbase*DM+hq*D,*Vh=V+rowbase*DM+hv*D;
  const unsigned lds0=(unsigned)(uintptr_t)shm;
  float*wsf=(float*)(shm+LDS_WS)+wid*64;
  const bf16*ksrc=Kh+(long)lane*DM+wid*8;
  const bf16*vsrc=Vh+(long)(16*(wid&3)+(lane>>2))*DM+(wid>>2)*32+(lane&3)*8;
  const unsigned kdst=lds0+LDS_K+wid*1024, vdst=lds0+LDS_V+wid*1024;
  #define DMA_K(t,slot) glds16(ksrc+(long)(t)*KVBLK*DM,(unsigned)__builtin_amdgcn_readfirstlane(kdst+(slot)))
  #define DMA_V(t,slot) glds16(vsrc+(long)(t)*KVBLK*DM,(unsigned)__builtin_amdgcn_readfirstlane(vdst+(slot)))
  const int vb0=(int)(lds0+LDS_V)+((lane>>4)&1)*32+(lane&3)*8+(4*hi+((lane&15)>>2))*64;
  const char*Kbase=shm+LDS_K; bf16x8 kf[8];
  const lds_cptr shm3=(lds_cptr)shm; const lds_cptr kp0=shm3+LDS_K+hi*1024+r32*16; const lds_cptr vp0=shm3+LDS_V+((lane>>4)&1)*32+(lane&3)*8+(4*hi+((lane&15)>>2))*64;
  const int NT=(q0+QB)/KVBLK;
  DMA_K(0,0);DMA_V(0,0);DMA_K(1,SLOTB);
  bf16x8 qr[4];
  #pragma unroll
  for(int d0=0;d0<4;++d0)qr[d0]=*reinterpret_cast<const bf16x8*>(&Qw[(long)r32*DM+d0*16+hi*8]);
  float mhat=0.f,l_reg=0.f;f32x16 o[2];o[0]=f32x16{};o[1]=f32x16{};f32x16 negm=f32x16{};asm volatile("":"+v"(negm));
  const int qrel=wid*QBLK+r32;
  #define CMASK(P0,P1,t) do{int jb_=(t)-(NT-4); if(jb_>=0)cmask(P0,P1,jb_,qrel,hi);}while(0)
  bool resc=false;
  #define START(P0,P1) do{ const float rm=rowmax(P0,P1); resc=false; \
    { const float dl=rm; mhat=fadd_s(mhat,dl); \
      _Pragma("unroll") for(int r=0;r<16;++r){P0[r]=fsub_s(P0[r],dl);P1[r]=fsub_s(P1[r],dl);} \
      _Pragma("unroll") for(int r=0;r<16;++r)negm[r]=-mhat; asm volatile("":"+v"(negm)); } \
    _Pragma("unroll") for(int r=0;r<16;++r)P0[r]=__builtin_amdgcn_exp2f(P0[r]); }while(0)
  #define RESC() do{ if(resc){ asm volatile("s_waitcnt lgkmcnt(0)":::"memory"); \
      _Pragma("unroll") for(int d_=0;d_<2;++d_) _Pragma("unroll") for(int r=0;r<16;++r)o[d_][r]*=wsf[crow(r,hi)]; } }while(0)
  f32x16 pA0,pA1,pB0,pB1;
  int sl_prev=0,sl_cur=0,sl_next=SLOTB;
  #define ROT() do{sl_prev=sl_cur;sl_cur=sl_next;sl_next=(sl_next==(NSLOT-1)*SLOTB)?0:sl_next+SLOTB;}while(0)
  DMA_K(2,2*SLOTB);
  WAIT_BAR(3);
  qkt(pA0,pA1,Kbase,qr,negm,r32,hi);asm volatile("s_nop 15\n\ts_nop 7":"+v"(pA0),"+v"(pA1));CMASK(pA0,pA1,0);
  START(pA0,pA1);
  _Pragma("unroll") for(int r=0;r<16;++r)pA1[r]=__builtin_amdgcn_exp2f(pA1[r]);
  WAIT_BAR(0);
  DMA_K(3,0);DMA_V(1,SLOTB);
  ROT();
  kload8(kf,kp0+sl_cur);
  WAIT_BAR(2);
  s16x4 vlo[8],vhi[8]; u32x4 pw0,pw1,pw2,pw3;
  #define PKW(P,B) cvtpk_s(P[B],P[B+1])
  #define PAF(k) __builtin_bit_cast(bf16x8,pw##k)
  #define VFR(i) (bf16x8){vlo[i][0],vlo[i][1],vlo[i][2],vlo[i][3],vhi[i][0],vhi[i][1],vhi[i][2],vhi[i][3]}
  #define PIN(x) asm volatile("":"+v"(x))
  #define MX3(a,b,c) __builtin_fmaxf(__builtin_fmaxf((a),(b)),(c))
  #define GAPA(MF,A0,A1,A2,A3,W0,W1,PW) do{ MF; sacc+=A0; sacc+=A1; sacc+=A2; sacc+=A3; PIN(sacc); W0; W1; PIN(PW); SBAR(); }while(0)
  #define EX(v) __builtin_amdgcn_exp2f(v)
  #define GAPB(MF,X,B) do{ MF; X[B]=EX(X[B]); X[B+1]=EX(X[B+1]); X[B+2]=EX(X[B+2]); X[B+3]=EX(X[B+3]); PIN(X); SBAR(); }while(0)
  #define VRD(i) do{ vlo[i]=vtr(vp_+(((i)>>2)*4096+((i)&3)*1024)); vhi[i]=vtr(vp_+(((i)>>2)*4096+((i)&3)*1024+512)); }while(0)
  #define KRD(G,j) do{ if(G){ kload2(kf,kp0+sl_next,j); SBAR(); } }while(0)
  #define STEP(C0,C1,P0,P1,t,GK,GV,GL) do{ SBAR(); \
    const lds_cptr vp_=vp0+sl_prev; \
    VRD(0); SBAR(); float sacc=(P0[0]+P0[1]); \
    GAPA(C0=__builtin_amdgcn_mfma_f32_32x32x16_bf16(kf[0],qr[0],negm,0,0,0), P0[2],P0[3],P0[4],P0[5],     pw0[0]=PKW(P0,0), pw0[1]=PKW(P0,2), pw0); \
    VRD(4); SBAR(); GAPA(C1=__builtin_amdgcn_mfma_f32_32x32x16_bf16(kf[1],qr[0],negm,0,0,0), P0[6],P0[7],P0[8],P0[9],     pw0[2]=PKW(P0,4), pw0[3]=PKW(P0,6), pw0); \
    VRD(1); SBAR(); GAPA(C0=__builtin_amdgcn_mfma_f32_32x32x16_bf16(kf[2],qr[1],C0,0,0,0),   P0[10],P0[11],P0[12],P0[13], pw1[0]=PKW(P0,8), pw1[1]=PKW(P0,10), pw1); \
    VRD(5); SBAR(); GAPA(C1=__builtin_amdgcn_mfma_f32_32x32x16_bf16(kf[3],qr[1],C1,0,0,0),   P0[14],P0[15],P1[0],P1[1],   pw1[2]=PKW(P0,12),pw1[3]=PKW(P0,14), pw1); \
    VRD(2); SBAR(); GAPA(C0=__builtin_amdgcn_mfma_f32_32x32x16_bf16(kf[4],qr[2],C0,0,0,0),   P1[2],P1[3],P1[4],P1[5],     pw2[0]=PKW(P1,0), pw2[1]=PKW(P1,2), pw2); \
    VRD(6); SBAR(); GAPA(C1=__builtin_amdgcn_mfma_f32_32x32x16_bf16(kf[5],qr[2],C1,0,0,0),   P1[6],P1[7],P1[8],P1[9],     pw2[2]=PKW(P1,4), pw2[3]=PKW(P1,6), pw2); \
    VRD(3); SBAR(); GAPA(C0=__builtin_amdgcn_mfma_f32_32x32x16_bf16(kf[6],qr[3],C0,0,0,0),   P1[10],P1[11],P1[12],P1[13], pw3[0]=PKW(P1,8), pw3[1]=PKW(P1,10), pw3); \
    VRD(7); SBAR(); GAPA(C1=__builtin_amdgcn_mfma_f32_32x32x16_bf16(kf[7],qr[3],C1,0,0,0),   P1[14],P1[15],0.f,0.f,       pw3[2]=PKW(P1,12),pw3[3]=PKW(P1,14), pw3); \
    l_reg+=sacc; \
    if(GK){DMA_K((t)+3,sl_cur);} if(GV){DMA_V((t)+1,sl_next);} \
    CMASK(C0,C1,t); \
    { float a=MX3(C0[0],C0[1],C1[0]),b=MX3(C0[2],C0[3],C1[1]); a=MX3(a,C1[2],C1[3]); \
      _Pragma("unroll") for(int r=4;r<16;r+=4){a=MX3(a,C0[r],C0[r+1]);b=MX3(b,C0[r+2],C0[r+3]);a=MX3(a,C1[r],C1[r+1]);b=MX3(b,C1[r+2],C1[r+3]);} \
      float rm=__builtin_fmaxf(a,b); { auto rr=__builtin_amdgcn_permlane32_swap(__float_as_uint(rm),__float_as_uint(rm),false,false); rm=__builtin_fmaxf(__uint_as_float(rr[0]),__uint_as_float(rr[1])); } \
      resc=false; \
      if(__builtin_expect(__any(rm>(float)THRL),0)){ const float dl=__builtin_fmaxf(rm,0.f); mhat+=dl; \
        _Pragma("unroll") for(int r=0;r<16;++r){C0[r]-=dl;C1[r]-=dl;} \
        _Pragma("unroll") for(int r=0;r<16;++r)negm[r]=-mhat; asm volatile("":"+v"(negm)); \
        const float f=__builtin_amdgcn_exp2f(-dl); l_reg*=f; if(hi==0)wsf[r32]=f; resc=true; } } \
    SBAR(); \
    GAPB(o[0]=__builtin_amdgcn_mfma_f32_32x32x16_bf16(PAF(0),VFR(0),o[0],0,0,0), C0,0); \
    GAPB(o[1]=__builtin_amdgcn_mfma_f32_32x32x16_bf16(PAF(0),VFR(4),o[1],0,0,0), C0,4); \
    KRD(GL,0); GAPB(o[0]=__builtin_amdgcn_mfma_f32_32x32x16_bf16(PAF(1),VFR(1),o[0],0,0,0), C0,8); \
    KRD(GL,1); GAPB(o[1]=__builtin_amdgcn_mfma_f32_32x32x16_bf16(PAF(1),VFR(5),o[1],0,0,0), C0,12); \
    KRD(GL,2); GAPB(o[0]=__builtin_amdgcn_mfma_f32_32x32x16_bf16(PAF(2),VFR(2),o[0],0,0,0), C1,0); \
    KRD(GL,3); GAPB(o[1]=__builtin_amdgcn_mfma_f32_32x32x16_bf16(PAF(2),VFR(6),o[1],0,0,0), C1,4); \
    GAPB(o[0]=__builtin_amdgcn_mfma_f32_32x32x16_bf16(PAF(3),VFR(3),o[0],0,0,0), C1,8); \
    GAPB(o[1]=__builtin_amdgcn_mfma_f32_32x32x16_bf16(PAF(3),VFR(7),o[1],0,0,0), C1,12); \
    }while(0)
  int t=1;
  #undef CMASK
  #define CMASK(P0,P1,t) do{}while(0)
  for(;t+5<NT;t+=2){
    STEP(pB0,pB1,pA0,pA1,t,true,true,true);     WAIT_BAR(2); RESC(); ROT();
    STEP(pA0,pA1,pB0,pB1,t+1,true,true,true);   WAIT_BAR(2); RESC(); ROT();
  }
  #undef CMASK
  #define CMASK(P0,P1,t) do{int jb_=(t)-(NT-4); if(jb_>=0)cmask(P0,P1,jb_,qrel,hi);}while(0)
  #define ENDW(tt) do{ if((tt)+3<NT){WAIT_BAR(2);} else if((tt)+2<NT){WAIT_BAR(1);} else {WAIT_BAR(0);} }while(0)
  for(;t+1<NT;t+=2){
    STEP(pB0,pB1,pA0,pA1,t,(t+3<NT),(t+1<NT),(t+1<NT));       ENDW(t);   RESC(); ROT();
    STEP(pA0,pA1,pB0,pB1,t+1,(t+4<NT),(t+2<NT),(t+2<NT));     ENDW(t+1); RESC(); ROT();
  }
  STEP(pB0,pB1,pA0,pA1,NT-1,false,false,false); RESC();
  { float sacc=pB0[0]+pB0[1]; _Pragma("unroll") for(int r=2;r<16;++r)sacc+=pB0[r]; _Pragma("unroll") for(int r=0;r<16;++r)sacc+=pB1[r]; l_reg+=sacc;
    pw0=(u32x4){PKW(pB0,0),PKW(pB0,2),PKW(pB0,4),PKW(pB0,6)};pw1=(u32x4){PKW(pB0,8),PKW(pB0,10),PKW(pB0,12),PKW(pB0,14)};pw2=(u32x4){PKW(pB1,0),PKW(pB1,2),PKW(pB1,4),PKW(pB1,6)};pw3=(u32x4){PKW(pB1,8),PKW(pB1,10),PKW(pB1,12),PKW(pB1,14)};
    SBAR(); pv(o,vb0+sl_cur,PAF(0),PAF(1),PAF(2),PAF(3)); }
  #undef PKW
  #undef PAF
  #undef VFR
  #undef PIN
  #undef MX3
  #undef GAPA
  #undef GAPB
  #undef EX
  #undef VRD
  #undef KRD
  #undef STEP
  #undef ENDW
  {auto rr=__builtin_amdgcn_permlane32_swap(__float_as_uint(l_reg),__float_as_uint(l_reg),false,false);l_reg=__uint_as_float(rr[0])+__uint_as_float(rr[1]);}
  if(hi==0)wsf[32+r32]=l_reg;asm volatile("s_waitcnt lgkmcnt(0)":::"memory");
  float rli[16];
  #pragma unroll
  for(int r=0;r<16;++r)rli[r]=__builtin_amdgcn_rcpf(wsf[32+crow(r,hi)]);
  bf16*Ow=O+(rowbase+q0+wid*QBLK)*(2*DM)+ho*D;
  { bf16*stg=(bf16*)(shm+LDS_OST)+wid*2048;
    #pragma unroll
    for(int r=0;r<16;++r){const int orow=crow(r,hi);
      #pragma unroll
      for(int d0=0;d0<2;++d0)stg[orow*64+d0*32+r32]=(bf16)f2bf(o[d0][r]*rli[r]);}
    asm volatile("s_waitcnt lgkmcnt(0)":::"memory");
    #pragma unroll
    for(int i=0;i<4;++i){const int row=i*8+(lane>>3),ch=lane&7; const u32x4 v=*(const u32x4*)(stg+row*64+ch*8); ATTN_STORE16(Ow+(long)row*(2*DM)+ch*8,v);} }
  asm volatile("s_waitcnt lgkmcnt(0)\n\ts_barrier":::"memory");
  #undef DMA_K
  #undef DMA_V
  #undef CMASK
  #undef START
  #undef RESC
  #undef ROT
}
}
#undef SBAR
#undef WAIT_BAR
__device__ __forceinline__ void mma_tile(f32x16& acc, const LAS bf16* A, int lda, const LAS bf16* Bt, int ldb, int K, int lane) {
    const LAS bf16* ap = A + (lane & 31) * lda + 8 * (lane >> 5); const LAS bf16* bp = Bt + (lane & 31) * ldb + 8 * (lane >> 5);
#pragma unroll
    for (int k0 = 0; k0 < 8; k0 += 4) { bf16x8 af[4], bf_[4];
#pragma unroll
        for (int k = 0; k < 4; ++k) { af[k] = *(const LAS bf16x8*)(ap + 16 * (k0 + k)); bf_[k] = *(const LAS bf16x8*)(bp + 16 * (k0 + k)); }
        __builtin_amdgcn_sched_barrier(0);
#pragma unroll
        for (int k = 0; k < 4; ++k) acc = __builtin_amdgcn_mfma_f32_32x32x16_bf16(af[k], bf_[k], acc, 0, 0, 0);
        __builtin_amdgcn_sched_barrier(0); }
    (void)K;
}
__device__ __forceinline__ f32x16 zero16() { f32x16 z;
#pragma unroll
    for (int i = 0; i < 16; ++i) z[i] = 0.f;
    return z; }
__device__ __forceinline__ float silu_f(float y) { return y / (1.f + __expf(-y)); }
__device__ __forceinline__ float softplus_f(float x) { return x > 20.f ? x : log1pf(expf(x)); }

constexpr int SP = 136;
constexpr int SSD_CM = 0, SSD_BM = 34816, SSD_XDT = 69632, SSD_XT = 87040, SSD_PM = 104448, SSD_F = 121856;
struct SsdIn { const bf16* XBC; const float* DT; const float* convw; const float* convb; const float* dtb; const float* alog; };

__device__ __forceinline__ void ssd_dt(const SsdIn& I, int t0, int h, LAS float* sdt, LAS float* sac, int wave, int lane) {
    if (wave == 0) {
        const float a = -expf(I.alog[h]), bias = I.dtb[h];
        const float d0 = softplus_f(I.DT[(size_t)(t0 + lane) * 16 + h] + bias), d1 = softplus_f(I.DT[(size_t)(t0 + 64 + lane) * 16 + h] + bias);
        float x0 = d0 * a, x1 = d1 * a;
#pragma unroll
        for (int o = 1; o < 64; o <<= 1) { const float t0_ = __shfl_up(x0, o), t1_ = __shfl_up(x1, o); if (lane >= o) { x0 += t0_; x1 += t1_; } }
        x1 += __shfl(x0, 63);
        sdt[lane] = d0; sdt[64 + lane] = d1; sac[lane] = x0; sac[64 + lane] = x1;
    }
}
__device__ __forceinline__ void ssd_conv8(const bf16* XBC, int b, int s, int ch0, const float (&w)[4][8], const float (&bs)[8], float (&y)[8]) {
#pragma unroll
    for (int q = 0; q < 8; ++q) y[q] = bs[q];
#pragma unroll
    for (int k = 0; k < 4; ++k) { const int ss = s - 3 + k;
        if (ss >= 0) { const u32x4 v = *(const u32x4*)(XBC + ((size_t)b * SEQ + ss) * 1536 + ch0);
            y[0] += w[k][0] * bflo(v.x); y[1] += w[k][1] * bfhi(v.x); y[2] += w[k][2] * bflo(v.y); y[3] += w[k][3] * bfhi(v.y);
            y[4] += w[k][4] * bflo(v.z); y[5] += w[k][5] * bfhi(v.z); y[6] += w[k][6] * bflo(v.w); y[7] += w[k][7] * bfhi(v.w); } }
#pragma unroll
    for (int q = 0; q < 8; ++q) y[q] = silu_f(y[q]);
}
__device__ __forceinline__ void ssd_ldw(const SsdIn& I, int ch0, float (&w)[4][8], float (&bs)[8]) {
#pragma unroll
    for (int k = 0; k < 4; ++k)
#pragma unroll
        for (int q = 0; q < 8; ++q) w[k][q] = I.convw[k * 1536 + ch0 + q];
#pragma unroll
    for (int q = 0; q < 8; ++q) bs[q] = I.convb[ch0 + q];
}

template <int NR> __device__ __forceinline__ void ssd_win_load(const bf16* XBC, int b, int s0, int ch0, u32x4 (&raw)[NR + 3]) {
#pragma unroll
    for (int k = 0; k < NR + 3; ++k) { const int ss = s0 - 3 + k; raw[k] = (ss >= 0) ? *(const u32x4*)(XBC + ((size_t)b * SEQ + ss) * 1536 + ch0) : (u32x4){0u, 0u, 0u, 0u}; }
}
template <int NR> __device__ __forceinline__ void ssd_win_conv(const u32x4 (&raw)[NR + 3], int j, const float (&w)[4][8], const float (&bs)[8], float (&y)[8]) {
#pragma unroll
    for (int q = 0; q < 8; ++q) y[q] = bs[q];
#pragma unroll
    for (int k = 0; k < 4; ++k) { const u32x4 v = raw[j + k];
        y[0] += w[k][0] * bflo(v.x); y[1] += w[k][1] * bfhi(v.x); y[2] += w[k][2] * bflo(v.y); y[3] += w[k][3] * bfhi(v.y);
        y[4] += w[k][4] * bflo(v.z); y[5] += w[k][5] * bfhi(v.z); y[6] += w[k][6] * bflo(v.w); y[7] += w[k][7] * bfhi(v.w); }
#pragma unroll
    for (int q = 0; q < 8; ++q) y[q] = silu_f(y[q]);
}

__device__ __forceinline__ void ssd_dt8(const SsdIn& I, int t0, int g, LAS float* sdt, LAS float* sac, int wave, int lane) {
    const int h = 8 * g + wave;
    const float a = -expf(I.alog[h]), bias = I.dtb[h];
    const float d0 = softplus_f(I.DT[(size_t)(t0 + lane) * 16 + h] + bias), d1 = softplus_f(I.DT[(size_t)(t0 + 64 + lane) * 16 + h] + bias);
    float x0 = d0 * a, x1 = d1 * a;
#pragma unroll
    for (int o = 1; o < 64; o <<= 1) { const float t0_ = __shfl_up(x0, o), t1_ = __shfl_up(x1, o); if (lane >= o) { x0 += t0_; x1 += t1_; } }
    x1 += __shfl(x0, 63);
    sdt[wave * 128 + lane] = d0; sdt[wave * 128 + 64 + lane] = d1; sac[wave * 128 + lane] = x0; sac[wave * 128 + 64 + lane] = x1;
}
constexpr int SSD_F8 = 121856;
__device__ __forceinline__ void phase_ssd_states(Frame& F, const SsdIn& I, bf16* ST, float* CDEC) {
    LAS bf16* XDT = (LAS bf16*)(F.lds + SSD_XDT); LAS bf16* BT = (LAS bf16*)(F.lds + SSD_BM);
    LAS float* sdt = (LAS float*)(F.lds + SSD_F8); LAS float* sac = sdt + 1024;
    const int tid = F.tid, lane = F.lane, wave = F.wave;
    for (int ug = blockIdx.x; ug < BATCH * 64 * 2; ug += F.G) {
        const int g = ug & 1, c = (ug >> 1) & 63, b = ug >> 7, t0 = b * SEQ + c * 128;
        const int lx = 2 * (tid >> 3), n0 = (tid & 15) * 8, chb = 1024 + g * 128 + n0, lb4 = 4 * (tid >> 4);
        u32x4 rb[7]; ssd_win_load<4>(I.XBC, b, c * 128 + lb4, chb, rb);
        u32x4 rx[5]; ssd_win_load<2>(I.XBC, b, c * 128 + lx, (8 * g) * 64 + (tid & 7) * 8, rx);
        ssd_dt8(I, t0, g, sdt, sac, wave, lane);
        { float w[4][8], bs[8]; ssd_ldw(I, chb, w, bs);
#pragma unroll
          for (int j = 0; j < 4; ++j) { float y[8]; ssd_win_conv<4>(rb, j, w, bs, y);
#pragma unroll
              for (int q = 0; q < 8; ++q) BT[(n0 + q) * SP + lb4 + j] = (bf16)f2bf(y[q]); } }
        __syncthreads();
        for (int hh = 0; hh < 8; ++hh) {
            const int h = 8 * g + hh, chx = h * 64 + (tid & 7) * 8, u = ((b * 64 + c) * 16) + h;
            const float alast = sac[hh * 128 + 127];
            { float w[4][8], bs[8]; ssd_ldw(I, chx, w, bs);
#pragma unroll
              for (int j = 0; j < 2; ++j) { float y[8]; ssd_win_conv<2>(rx, j, w, bs, y); const int l = lx + j; const float d = sdt[hh * 128 + l] * __expf(alast - sac[hh * 128 + l]);
#pragma unroll
                  for (int q = 0; q < 8; ++q) XDT[((tid & 7) * 8 + q) * SP + l] = (bf16)f2bf(y[q] * d); } }
            if (hh < 7) ssd_win_load<2>(I.XBC, b, c * 128 + lx, (h + 1) * 64 + (tid & 7) * 8, rx);
            __syncthreads();
            { const int pb = wave & 1, nb = wave >> 1; f32x16 acc = zero16();
              mma_tile(acc, XDT + pb * 32 * SP, SP, BT + nb * 32 * SP, SP, 128, lane);
              bf16* dst = ST + (size_t)u * 8192 + nb * 32 + (lane & 31);
#pragma unroll
              for (int r = 0; r < 16; ++r) dst[(pb * 32 + crow(r, lane >> 5)) * 128] = (bf16)f2bf(acc[r]); }
            if (tid == 0) CDEC[u] = __expf(alast);
            __syncthreads();
        }
    }
}
__device__ __forceinline__ void phase_ssd_scan(Frame& F, bf16* ST, const float* CDEC) {
    for (int e = blockIdx.x * NTHR + F.tid; e < BATCH * 16 * 4096; e += F.G * NTHR) {
        const int pn = (e & 4095) * 2, h = (e >> 12) & 15, b = e >> 16;
        unsigned* p = (unsigned*)(ST + ((size_t)b * 64 * 16 + h) * 8192 + pn); const float* dc = CDEC + b * 64 * 16 + h;
        float h0 = 0.f, h1 = 0.f;
        for (int c0 = 0; c0 < 64; c0 += 16) { unsigned sv[16]; float d[16];
#pragma unroll
            for (int i = 0; i < 16; ++i) { sv[i] = p[(size_t)(c0 + i) * 16 * 4096]; d[i] = dc[(c0 + i) * 16]; }
#pragma unroll
            for (int i = 0; i < 16; ++i) { p[(size_t)(c0 + i) * 16 * 4096] = pk2(h0, h1); h0 = h0 * d[i] + bflo(sv[i]); h1 = h1 * d[i] + bfhi(sv[i]); } }
    }
}
__device__ __forceinline__ void phase_ssd_out(Frame& F, const SsdIn& I, const bf16* ST, const bf16* Z, const float* Dskip, bf16* YS) {
    LAS bf16* Cm = (LAS bf16*)(F.lds + SSD_CM); LAS bf16* Bm = (LAS bf16*)(F.lds + SSD_BM); LAS bf16* XDT = (LAS bf16*)(F.lds + SSD_XDT); LAS bf16* XT = (LAS bf16*)(F.lds + SSD_XT); LAS bf16* Pm = (LAS bf16*)(F.lds + SSD_PM);
    LAS float* sdt = (LAS float*)(F.lds + SSD_F8); LAS float* sac = sdt + 1024;
    const int tid = F.tid, lane = F.lane, wave = F.wave, hi = lane >> 5;
    for (int ug = blockIdx.x; ug < BATCH * 64 * 2; ug += F.G) {
        const int g = ug & 1, c = (ug >> 1) & 63, b = ug >> 7, t0 = b * SEQ + c * 128;
        const int lx = 2 * (tid >> 3), n0 = (tid & 15) * 8, chb = 1024 + g * 128 + n0, chc = chb + 256, lb4 = 4 * (tid >> 4);
        u32x4 rb[7], rc[7]; ssd_win_load<4>(I.XBC, b, c * 128 + lb4, chb, rb); ssd_win_load<4>(I.XBC, b, c * 128 + lb4, chc, rc);
        u32x4 rx[5]; ssd_win_load<2>(I.XBC, b, c * 128 + lx, (8 * g) * 64 + (tid & 7) * 8, rx);
        const u32x4* stsrc = (const u32x4*)(ST + (size_t)(((b * 64 + c) * 16) + 8 * g) * 8192 + (tid >> 3) * 128 + (tid & 7) * 16);
        u32x4 pa0 = stsrc[0], pa1 = stsrc[1];
        ssd_dt8(I, t0, g, sdt, sac, wave, lane);
        { float w[4][8], bs[8]; ssd_ldw(I, chb, w, bs);
#pragma unroll
          for (int j = 0; j < 4; ++j) { float y[8]; ssd_win_conv<4>(rb, j, w, bs, y);
              u32x4 o; o.x = cvtpk(y[0], y[1]); o.y = cvtpk(y[2], y[3]); o.z = cvtpk(y[4], y[5]); o.w = cvtpk(y[6], y[7]); *(LAS u32x4*)(Bm + (lb4 + j) * SP + n0) = o; } }
        { float w[4][8], bs[8]; ssd_ldw(I, chc, w, bs);
#pragma unroll
          for (int j = 0; j < 4; ++j) { float y[8]; ssd_win_conv<4>(rc, j, w, bs, y);
              u32x4 o; o.x = cvtpk(y[0], y[1]); o.y = cvtpk(y[2], y[3]); o.z = cvtpk(y[4], y[5]); o.w = cvtpk(y[6], y[7]); *(LAS u32x4*)(Cm + (lb4 + j) * SP + n0) = o; } }
        __syncthreads();
        const int lb = wave & 3;
        f32x16 cb[2];
#pragma unroll
        for (int k = 0; k < 2; ++k) { const int sb = (wave >> 2) + 2 * k; cb[k] = zero16(); if (sb <= lb) mma_tile(cb[k], Cm + lb * 32 * SP, SP, Bm + sb * 32 * SP, SP, 128, lane); }
        __syncthreads();
        for (int hh = 0; hh < 8; ++hh) {
            const int h = 8 * g + hh, chx = h * 64 + (tid & 7) * 8;
            const LAS float* ac = sac + hh * 128;
#pragma unroll
            for (int k = 0; k < 2; ++k) { const int sb = (wave >> 2) + 2 * k, sidx = sb * 32 + (lane & 31); const float as = ac[sidx];
#pragma unroll
                for (int r = 0; r < 16; ++r) { const int l = lb * 32 + crow(r, hi); const float wv = (sb <= lb && sidx <= l) ? cb[k][r] * __expf(ac[l] - as) : 0.f; Bm[l * SP + sidx] = (bf16)f2bf(wv); } }
            { float w[4][8], bs[8]; ssd_ldw(I, chx, w, bs);
#pragma unroll
              for (int j = 0; j < 2; ++j) { float y[8]; ssd_win_conv<2>(rx, j, w, bs, y); const int l = lx + j; const float d = sdt[hh * 128 + l];
#pragma unroll
                  for (int q = 0; q < 8; ++q) { XDT[((tid & 7) * 8 + q) * SP + l] = (bf16)f2bf(y[q] * d); XT[((tid & 7) * 8 + q) * SP + l] = (bf16)f2bf(y[q]); } } }
            { const int p = tid >> 3, pn0 = (tid & 7) * 16;
              *(LAS u32x4*)(Pm + p * SP + pn0) = pa0; *(LAS u32x4*)(Pm + p * SP + pn0 + 8) = pa1; }
            if (hh < 7) { ssd_win_load<2>(I.XBC, b, c * 128 + lx, (h + 1) * 64 + (tid & 7) * 8, rx);
                const u32x4* nsrc = stsrc + (size_t)(hh + 1) * 1024; pa0 = nsrc[0]; pa1 = nsrc[1]; }
            __syncthreads();
            { const int pb = wave >> 2; f32x16 a1 = zero16(), a2 = zero16();
              mma_tile(a1, Bm + lb * 32 * SP, SP, XDT + pb * 32 * SP, SP, 128, lane);
              mma_tile(a2, Cm + lb * 32 * SP, SP, Pm + pb * 32 * SP, SP, 128, lane);
              const int p = pb * 32 + (lane & 31); const float dsk = Dskip[h];
              bf16 zr[16];
#pragma unroll
              for (int r = 0; r < 16; ++r) zr[r] = Z[(size_t)(t0 + lb * 32 + crow(r, hi)) * 1024 + h * 64 + p];
#pragma unroll
              for (int r = 0; r < 16; ++r) { const int l = lb * 32 + crow(r, hi); const size_t o = (size_t)(t0 + l) * 1024 + h * 64 + p;
                  const float y = a1[r] + __expf(ac[l]) * a2[r] + dsk * bf2f(XT[p * SP + l]); const float z = bf2f(zr[r]);
                  YS[o] = (bf16)f2bf(y * silu_f(z)); } }
            __syncthreads();
        }
    }
}
__device__ __forceinline__ void phase_post0(Frame& F, const Args& a, const bf16* OV, const bf16* YS, bf16* YMIX) {
    const int lane = F.lane;
    const float lam = expf(wave_sum(a.in[5][lane] * a.in[6][lane])) - expf(wave_sum(a.in[7][lane] * a.in[8][lane])) + 0.2f;
    const float g0 = a.in[9][2 * lane] * 0.8f, g1 = a.in[9][2 * lane + 1] * 0.8f;
    const int gw = blockIdx.x * NWAVES + F.wave, NGW = F.G * NWAVES;
#define POST_LOAD(P0, P1, YV, tt) do { const unsigned* ov_ = (const unsigned*)(OV + (size_t)(tt) * 2048); \
        _Pragma("unroll") for (int h = 0; h < 8; ++h) { P0[h] = ov_[h * 128 + lane]; P1[h] = ov_[h * 128 + 64 + lane]; } \
        _Pragma("unroll") for (int gq = 0; gq < 2; ++gq) YV[gq] = *(const u32x4*)(YS + (size_t)(tt) * 1024 + gq * 512 + lane * 8); } while (0)
#define POST_DO(P0, P1, YV, tt) do { unsigned* ym = (unsigned*)(YMIX + (size_t)(tt) * 2048); \
        _Pragma("unroll") for (int h = 0; h < 8; ++h) { const unsigned p0 = P0[h], p1 = P1[h]; \
            const float d0 = bflo(p0) - lam * bflo(p1), d1 = bfhi(p0) - lam * bfhi(p1); \
            const float rs = 1.f / sqrtf(wave_sum(d0 * d0 + d1 * d1) * (1.f / 128.f) + 1e-5f); \
            ym[h * 64 + lane] = pk2(d0 * rs * g0, d1 * rs * g1); } \
        _Pragma("unroll") for (int gq = 0; gq < 2; ++gq) { const u32x4 v = YV[gq]; \
            float y[8] = {bflo(v.x), bfhi(v.x), bflo(v.y), bfhi(v.y), bflo(v.z), bfhi(v.z), bflo(v.w), bfhi(v.w)}; float ss = 0.f; \
            _Pragma("unroll") for (int q = 0; q < 8; ++q) ss += y[q] * y[q]; \
            const float rs = 1.f / sqrtf(wave_sum(ss) * (1.f / 512.f) + 1e-5f); const f32x4 n0 = ng[gq][0], n1 = ng[gq][1]; \
            u32x4 o; o.x = pk2(y[0] * rs * n0.x, y[1] * rs * n0.y); o.y = pk2(y[2] * rs * n0.z, y[3] * rs * n0.w); o.z = pk2(y[4] * rs * n1.x, y[5] * rs * n1.y); o.w = pk2(y[6] * rs * n1.z, y[7] * rs * n1.w); \
            *(u32x4*)(YMIX + (size_t)(tt) * 2048 + 1024 + gq * 512 + lane * 8) = o; } } while (0)
    f32x4 ng[2][2];
#pragma unroll
    for (int gq = 0; gq < 2; ++gq) { ng[gq][0] = *(const f32x4*)(a.in[15] + gq * 512 + lane * 8); ng[gq][1] = *(const f32x4*)(a.in[15] + gq * 512 + lane * 8 + 4); }
    unsigned a0[8], a1[8], b0[8], b1[8]; u32x4 ay[2], by[2];
    int t = gw; if (t >= NTOK) return;
    POST_LOAD(a0, a1, ay, t);
    while (true) {
        const int t1 = t + NGW, t1c = t1 < NTOK ? t1 : t;
        POST_LOAD(b0, b1, by, t1c);
        POST_DO(a0, a1, ay, t);
        if (t1 >= NTOK) break;
        const int t2 = t1 + NGW, t2c = t2 < NTOK ? t2 : t1;
        POST_LOAD(a0, a1, ay, t2c);
        POST_DO(b0, b1, by, t1);
        if (t2 >= NTOK) break;
        t = t2;
    }
#undef POST_LOAD
#undef POST_DO
}
__device__ __forceinline__ void phase_diffattn(Frame& F, const Args& a, const bf16* Q, const bf16* K, const bf16* V, bf16* OV) {
    const int s = F.vcu & 7;
    for (int i = 0; i < 8; ++i) {
        const int bh = (F.vcu >> 3) + 32 * (i >> 2);
        if (bh < 64) {
            const int b = bh >> 5, vh = bh & 31, h = vh >> 2, c = (vh >> 1) & 1, vhalf = vh & 1, ii = i & 3;
            const int qb = (ii == 0) ? s : (ii == 1) ? 15 - s : (ii == 2) ? 16 + s : 31 - s;
            attn_body::attn_unit<8>(b, 2 * h + c, 2 * h + vhalf, vh, qb, Q, K, V, OV, (char*)F.lds);
        }
#if MOE_CVT_IN_ATTN
        if (i == s) { tr_moe_layer(F, a, 0); __syncthreads(); }
#endif
    }
}
constexpr int CMP_HS = 0, CMP_W2 = 17408;
struct CmpA { const bf16* src; const float* pe; int r0;
    struct Raw { bf16x8 x; f32x4 p0, p1; };
    __device__ __forceinline__ Raw raw(int r, int kc) const { Raw q; q.x = *(const bf16x8*)(src + (size_t)(r0 + r) * 2048 + kc * 8); q.p0 = *(const f32x4*)(pe + kc * 8); q.p1 = *(const f32x4*)(pe + kc * 8 + 4); return q; }
    __device__ __forceinline__ bf16x8 fin(const Raw& q, int) const { const u32x4 v = __builtin_bit_cast(u32x4, q.x); const f32x4 p0 = q.p0, p1 = q.p1;
        u32x4 o; o.x = pk2(bflo(v.x) + p0.x, bfhi(v.x) + p0.y); o.y = pk2(bflo(v.y) + p0.z, bfhi(v.y) + p0.w); o.z = pk2(bflo(v.z) + p1.x, bfhi(v.z) + p1.y); o.w = pk2(bflo(v.w) + p1.z, bfhi(v.w) + p1.w);
        return __builtin_bit_cast(bf16x8, o); } };
struct RowsB { const bf16* w; int ld;
    __device__ __forceinline__ bf16x8 operator()(int r, int kc) const { return *(const bf16x8*)(w + (size_t)r * ld + kc * 8); } };
struct RowsA { const bf16* a; int ld; int r0; typedef bf16x8 Raw;
    __device__ __forceinline__ bf16x8 raw(int r, int kc) const { return *(const bf16x8*)(a + (size_t)(r0 + r) * ld + kc * 8); }
    __device__ __forceinline__ bf16x8 fin(bf16x8 x, int) const { return x; } };
__device__ __forceinline__ float gelu_tanh(float x) { const float u = 0.7978845608028654f * (x + 0.044715f * x * x * x); const float th = 1.f - 2.f / (1.f + __expf(2.f * u)); return 0.5f * x * (1.f + th); }

__device__ __forceinline__ void phase_nsa_prep(Frame& F, const Args& a) {
    unsigned char* ws = F.ws_;
    const int tid = F.tid, lane = F.lane, wave = F.wave, hi = lane >> 5, wr = wave & 1, wc = wave >> 1;
    for (int u = blockIdx.x; u < 128; u += F.G) {
        const int kv = u & 1, rt = u >> 1, r0 = rt * 64;
        CmpA af{(const bf16*)(ws + WS_MIX + (kv ? MY_VC : MY_KC)), kv ? a.in[19] : a.in[18], r0}; RowsB bfn{(const bf16*)(ws + (kv ? WS_W1VT : WS_W1KT)), 4096};
        const f32x16 acc = small_gemm<4, 2>(F.lds, 4096, af, bfn, tid);
        LAS bf16* Hs = (LAS bf16*)(F.lds + CMP_HS); LAS bf16* W2 = (LAS bf16*)(F.lds + CMP_W2);
#pragma unroll
        for (int r = 0; r < 16; ++r) Hs[(wr * 32 + crow(r, hi)) * 136 + wc * 32 + (lane & 31)] = (bf16)f2bf(gelu_tanh(acc[r]));
        { const bf16* w2 = (const bf16*)(ws + (kv ? WS_W2VT : WS_W2KT));
#pragma unroll
          for (int i = 0; i < 4; ++i) { const int c = tid + NTHR * i, n = c >> 4, kc = c & 15; *(LAS u32x4*)(W2 + n * 136 + kc * 8) = *(const u32x4*)(w2 + n * 128 + kc * 8); } }
        __syncthreads();
        f32x16 o2 = zero16();
        mma_tile(o2, Hs + wr * 32 * 136, 136, W2 + wc * 32 * 136, 136, 128, lane);
        const int n = wc * 32 + (lane & 31);
        if (kv == 0) { bf16* dst = (bf16*)(ws + WS_MIX + MY_KCMP);
#pragma unroll
            for (int r = 0; r < 16; ++r) dst[(size_t)(r0 + wr * 32 + crow(r, hi)) * 128 + n] = (bf16)f2bf(o2[r]); }
        else { bf16* dst = (bf16*)(ws + WS_MIX + MY_VCT);
#pragma unroll
            for (int r = 0; r < 16; ++r) { const int R = r0 + wr * 32 + crow(r, hi), bg = R >> 9, nr = R & 511; dst[((size_t)bg * 128 + n) * 512 + nr] = (nr == 511) ? (bf16)0 : (bf16)f2bf(o2[r]); } }
        __syncthreads();
    }
    for (int u = (F.G == 256) ? ((int)blockIdx.x - 128) * 2 : (int)blockIdx.x, ue = (F.G == 256) ? u + 2 : NTOK / 64, ustep = (F.G == 256) ? 1 : F.G; u >= 0 && u < ue; u += ustep) {
        const int r0 = u * 64;
        RowsA af{(const bf16*)(ws + WS_XB), 2048, r0}; RowsB bfn{(const bf16*)(ws + WS_WGT), 2048};
        const f32x16 acc = small_gemm<4, 2>(F.lds, 2048, af, bfn, tid);
        const int col = wc * 32 + (lane & 31); float* G = (float*)(ws + WS_MIX + MY_GATES);
        if (col < 48) {
#pragma unroll
            for (int r = 0; r < 16; ++r) G[(size_t)(r0 + wr * 32 + crow(r, hi)) * 48 + col] = 1.f / (1.f + __expf(-acc[r])); }
    }
}

constexpr int NKP = 136, NVP = 68;
constexpr int NSA_KT = 0, NSA_VT = 34816, NSA_IMP = 71680, NSA_SELM = 104448, NSA_WM = 105472;
struct NsaT { const bf16* Q; const bf16* KCMP; const bf16* VCT; const bf16* KS; const bf16* VST; const bf16* KW; const bf16* VWT; const float* GATES; bf16* O; bf16* OC; bf16* OS; };

__device__ __forceinline__ int next_bit128(unsigned long long lo, unsigned long long hi, int from) {
    if (from < 64) { const unsigned long long x = lo & (~0ull << from); if (x) return __builtin_ctzll(x); from = 64; }
    if (from < 128) { const unsigned long long x = hi & (~0ull << (from - 64)); if (x) return 64 + __builtin_ctzll(x); }
    return 128;
}
template <int MODE>
__device__ __forceinline__ void nsa_pass(Frame& F, const bf16* Kb, const bf16* VTb, const int vpitch, const int qb, const int first, const int last, const unsigned long long um_lo, const unsigned long long um_hi,
                                         const unsigned long long wm_lo, const unsigned long long wm_hi, const unsigned long long sm_lo, const unsigned long long sm_hi,
                                         const bf16x8 (&qf)[8], float& m, float& l, f32x16 (&o)[4], const float inv_l, const int tl, const int t,
                                         u32x4 (&kr)[2], u32x4 (&vr)[2], const bool pre, const bf16* Kn, const bf16* Vn, const int vpn, const int tn) {
    int tid_ = threadIdx.x; asm volatile("" : "+v"(tid_));
    const int tid = tid_, lane = tid & 63, q = lane & 31, hi = lane >> 5;
    LAS bf16* KT = (LAS bf16*)(F.lds + NSA_KT); LAS bf16* VT = (LAS bf16*)(F.lds + NSA_VT); LAS float* IMP = (LAS float*)(F.lds + NSA_IMP);
    int cur = (MODE == 2) ? next_bit128(um_lo, um_hi, first) : first;
    auto dummy = 0; (void)dummy;
#define NSA_LOAD(tile) do { const bf16* ks_ = Kb + (size_t)(tile) * 64 * 128; \
        _Pragma("unroll") for (int i_ = 0; i_ < 2; ++i_) { const int c_ = tid + NTHR * i_; kr[i_] = *(const u32x4*)(ks_ + (c_ >> 4) * 128 + (c_ & 15) * 8); } \
        if (MODE != 0) { const bf16* vs_ = VTb + (size_t)(tile) * 64; _Pragma("unroll") for (int i_ = 0; i_ < 2; ++i_) { const int c_ = tid + NTHR * i_; vr[i_] = *(const u32x4*)(vs_ + (size_t)(c_ >> 3) * vpitch + (c_ & 7) * 8); } } } while (0)
#define NSA_WRITE(b_) do { LAS bf16* Kw_ = KT + (b_) * (64 * NKP); LAS bf16* Vw_ = VT + (b_) * (128 * NVP); \
        _Pragma("unroll") for (int i = 0; i < 2; ++i) { const int c = tid + NTHR * i; *(LAS u32x4*)(Kw_ + (c >> 4) * NKP + (c & 15) * 8) = kr[i]; } \
        if (MODE != 0) { _Pragma("unroll") for (int i = 0; i < 2; ++i) { const int c = tid + NTHR * i; LAS u32x2* d = (LAS u32x2*)(Vw_ + (c >> 3) * NVP + (c & 7) * 8); u32x2 a0, a1; a0.x = vr[i].x; a0.y = vr[i].y; a1.x = vr[i].z; a1.y = vr[i].w; d[0] = a0; d[1] = a1; } } } while (0)
    if (!pre) NSA_LOAD(cur);
    NSA_WRITE(0);
    int nxt = (MODE == 2) ? next_bit128(um_lo, um_hi, cur + 1) : cur + 1;
    if (nxt <= last) NSA_LOAD(nxt);
    int buf = 0;
    while (true) {
        LAS bf16* Kt = KT + buf * (64 * NKP); LAS bf16* Vt = VT + buf * (128 * NVP);
        __syncthreads();
        int nn = 1 << 20;
        if (nxt <= last) { NSA_WRITE(buf ^ 1); nn = (MODE == 2) ? next_bit128(um_lo, um_hi, nxt + 1) : nxt + 1; if (nn <= last) NSA_LOAD(nn); }
        else if (Kn != nullptr) { const bf16* ks_ = Kn + (size_t)tn * 64 * 128;
#pragma unroll
            for (int i_ = 0; i_ < 2; ++i_) { const int c_ = tid + NTHR * i_; kr[i_] = *(const u32x4*)(ks_ + (c_ >> 4) * 128 + (c_ & 15) * 8); }
            if (Vn != nullptr) { const bf16* vs_ = Vn + (size_t)tn * 64;
#pragma unroll
                for (int i_ = 0; i_ < 2; ++i_) { const int c_ = tid + NTHR * i_; vr[i_] = *(const u32x4*)(vs_ + (size_t)(c_ >> 3) * vpn + (c_ & 7) * 8); } } }
        bool active = true;
        if (MODE == 2) active = (cur < 64) ? ((wm_lo >> cur) & 1ull) : ((wm_hi >> (cur - 64)) & 1ull);
        if (active) {
            f32x16 sT[2]; sT[0] = zero16(); sT[1] = zero16();
            {
                const LAS bf16* kp = Kt + q * NKP + 8 * hi;
#define NSA_KF(i) (*(const LAS bf16x8*)(kp + ((i) >> 3) * 32 * NKP + 16 * ((i) & 7)))
                bf16x8 kf[4];
#pragma unroll
                for (int i = 0; i < 4; ++i) kf[i] = NSA_KF(i);
                __builtin_amdgcn_sched_barrier(0);
#pragma unroll
                for (int i = 0; i < 16; ++i) { const bf16x8 a = kf[i & 3];
                    if (i + 4 < 16) kf[i & 3] = NSA_KF(i + 4);
                    sT[i >> 3] = __builtin_amdgcn_mfma_f32_32x32x16_bf16(a, qf[i & 7], sT[i >> 3], 0, 0, 0); __builtin_amdgcn_sched_barrier(0); }
#undef NSA_KF
            }
            const bool mysel = (MODE == 2) ? (((cur < 64) ? (sm_lo >> cur) : (sm_hi >> (cur - 64))) & 1ull) != 0ull : true;
            bool need;
            { const int tmin = 64 * qb + 8 * (int)__builtin_amdgcn_readfirstlane(tid >> 6);
              if (MODE <= 1) need = (64 * cur + 63) > ((tmin >= 31) ? ((tmin - 31) >> 4) : -1);
              else if (MODE == 2) need = (cur == qb);
              else need = (cur == qb) || (cur == qb - 8); }
            if (need) {
                int tlo = tl, to = t, hio = hi; asm volatile("" : "+v"(tlo), "+v"(to), "+v"(hio));
#pragma unroll
                for (int half = 0; half < 2; ++half)
#pragma unroll
                    for (int r = 0; r < 16; ++r) { const int kv = 32 * half + crow(r, hio); bool ok;
                        if (MODE <= 1) ok = (64 * cur + kv) <= ((to >= 31) ? ((to - 31) >> 4) : -1);
                        else if (MODE == 2) ok = mysel && (kv <= tlo);
                        else { const int pos = 64 * cur + kv; ok = (pos <= to) && (pos > to - 512); }
                        if (!ok) sT[half][r] = -INFINITY; }
            }
            const bool lane_off = (MODE == 2) && !need && !mysel;
            if (MODE == 1) {
#pragma unroll
                for (int half = 0; half < 2; ++half)
#pragma unroll
                    for (int r = 0; r < 16; ++r) sT[half][r] = fast_exp2(sT[half][r] - m) * inv_l;
#pragma unroll
                for (int half = 0; half < 2; ++half)
#pragma unroll
                    for (int i = 0; i < 4; ++i) { float v = (sT[half][4 * i] + sT[half][4 * i + 1]) + (sT[half][4 * i + 2] + 0.5f * sT[half][4 * i + 3]), w = 0.5f * sT[half][4 * i + 3];
                        v += __shfl_xor(v, 1); w += __shfl_xor(w, 1); v += __shfl_xor(v, 2); w += __shfl_xor(w, 2);
                        const int msel = 16 * cur + 8 * half + 2 * i + hi;
                        if ((q & 3) == 0) { (void)__hip_atomic_fetch_add(&IMP[tl * 128 + msel], v, __ATOMIC_RELAXED, __HIP_MEMORY_SCOPE_WORKGROUP); if (msel + 1 < 128) (void)__hip_atomic_fetch_add(&IMP[tl * 128 + msel + 1], w, __ATOMIC_RELAXED, __HIP_MEMORY_SCOPE_WORKGROUP); } }
            } else {
                float mx = sT[0][0];
#pragma unroll
                for (int r = 1; r < 16; ++r) mx = fmaxf(mx, sT[0][r]);
#pragma unroll
                for (int r = 0; r < 16; ++r) mx = fmaxf(mx, sT[1][r]);
                mx = lane_off ? -INFINITY : mx;
                mx = fmaxf(mx, __shfl_xor(mx, 32));
                const float mn = (mx > m + 8.f) ? mx : m, al = fast_exp2(m - mn); m = mn;
                const float msub = lane_off ? INFINITY : mn; const f32x2 ms2 = {msub, msub}; f32x2 ps2 = {0.f, 0.f};
#pragma unroll
                for (int half = 0; half < 2; ++half)
#pragma unroll
                    for (int r = 0; r < 16; r += 2) { const f32x2 sv = {sT[half][r], sT[half][r + 1]}; const f32x2 d = sv - ms2; f32x2 p; p.x = fast_exp2(d.x); p.y = fast_exp2(d.y); sT[half][r] = p.x; sT[half][r + 1] = p.y; ps2 += p; }
                const float ps = ps2.x + ps2.y;
                l = l * al + ps;
                if (MODE >= 2) { if (__any(al != 1.f)) {
#pragma unroll
                    for (int db = 0; db < 4; ++db)
#pragma unroll
                        for (int r = 0; r < 16; ++r) o[db][r] *= al; } }
            }
            if (MODE != 0) {
                bf16x8 pf[4];
#pragma unroll
                for (int ks = 0; ks < 4; ++ks) { const int half = ks >> 1, s8 = (ks & 1) * 8; u32x4 w;
                    w.x = cvtpk(sT[half][s8 + 0], sT[half][s8 + 1]); w.y = cvtpk(sT[half][s8 + 2], sT[half][s8 + 3]); w.z = cvtpk(sT[half][s8 + 4], sT[half][s8 + 5]); w.w = cvtpk(sT[half][s8 + 6], sT[half][s8 + 7]);
                    pf[ks] = __builtin_bit_cast(bf16x8, w); }
                {
                    const LAS bf16* vp = Vt + q * NVP + 4 * hi;
#define NSA_VLO(i) (*(const LAS u32x2*)(vp + ((i) >> 2) * 32 * NVP + 16 * ((i) & 3)))
#define NSA_VHI(i) (*(const LAS u32x2*)(vp + ((i) >> 2) * 32 * NVP + 16 * ((i) & 3) + 8))
                    u32x2 vlo[4], vhi[4];
#pragma unroll
                    for (int i = 0; i < 4; ++i) { vlo[i] = NSA_VLO(i); vhi[i] = NSA_VHI(i); }
                    __builtin_amdgcn_sched_barrier(0);
#pragma unroll
                    for (int i = 0; i < 16; ++i) { u32x4 a; a.x = vlo[i & 3].x; a.y = vlo[i & 3].y; a.z = vhi[i & 3].x; a.w = vhi[i & 3].y;
                        if (i + 4 < 16) { vlo[i & 3] = NSA_VLO(i + 4); vhi[i & 3] = NSA_VHI(i + 4); }
                        o[i >> 2] = __builtin_amdgcn_mfma_f32_32x32x16_bf16(__builtin_bit_cast(bf16x8, a), pf[i & 3], o[i >> 2], 0, 0, 0); __builtin_amdgcn_sched_barrier(0); }
#undef NSA_VLO
#undef NSA_VHI
                }
            }
        }
        if (nxt > last) break;
        cur = nxt; nxt = nn; buf ^= 1;
    }
#undef NSA_LOAD
#undef NSA_WRITE
    __syncthreads();
}

__device__ __forceinline__ void nsa_load_q(bf16x8 (&qf)[8], const bf16* Q, size_t trow, int head, int hi) {
#pragma unroll
    for (int d0 = 0; d0 < 8; ++d0) qf[d0] = *(const bf16x8*)(Q + trow * 2048 + head * 128 + 16 * d0 + 8 * hi);
}
__device__ __forceinline__ void nsa_unit(Frame& F, const NsaT& T, const int b, const int g, const int qb) {
    LAS float* IMP = (LAS float*)(F.lds + NSA_IMP); LAS unsigned long long* SELM = (LAS unsigned long long*)(F.lds + NSA_SELM); LAS unsigned long long* WM = (LAS unsigned long long*)(F.lds + NSA_WM);
    const int bg = b * 4 + g;
    u32x4 kr[2], vr[2];
    { int tid = threadIdx.x; asm volatile("" : "+v"(tid));
#pragma unroll
      for (int i = 0; i < 16; ++i) IMP[tid + NTHR * i] = 0.f; }
    __syncthreads();
    { int tid = threadIdx.x; asm volatile("" : "+v"(tid)); const int lane = tid & 63, wave = __builtin_amdgcn_readfirstlane(tid >> 6), q = lane & 31, hi = lane >> 5;
      const int tl = 8 * wave + (q >> 2), head = 4 * g + (q & 3), t = 64 * qb + tl; const size_t trow = (size_t)b * SEQ + t;
      bf16x8 qf[8]; nsa_load_q(qf, T.Q, trow, head, hi);
      const int ntc = min(8, (4 * qb + 2) / 64 + 1);
      const bf16* Kc = T.KCMP + (size_t)bg * 512 * 128; const bf16* Vc = T.VCT + (size_t)bg * 128 * 512;
      float m = -1e30f, l = 0.f; f32x16 o[4];
#pragma unroll
      for (int db = 0; db < 4; ++db) o[db] = zero16();
      const float g0 = T.GATES[trow * 48 + head * 3];
      nsa_pass<0>(F, Kc, Vc, 512, qb, 0, ntc - 1, 0ull, 0ull, 0ull, 0ull, 0ull, 0ull, qf, m, l, o, 0.f, tl, t, kr, vr, false, Kc, Vc, 512, 0);
      const float lt = l + __shfl_xor(l, 32); const float inv = lt > 0.f ? 1.f / lt : 0.f;
      nsa_pass<1>(F, Kc, Vc, 512, qb, 0, ntc - 1, 0ull, 0ull, 0ull, 0ull, 0ull, 0ull, qf, m, l, o, inv, tl, t, kr, vr, true, T.KS + (size_t)bg * SEQ * 128, T.VST + (size_t)bg * 128 * SEQ, SEQ, 0);
      bf16* op = T.OC + trow * 2048 + head * 128 + 64 * hi;
#pragma unroll
      for (int p = 0; p < 8; ++p) { const int d0 = (2 * p) >> 2, i0 = (2 * p) & 3, d1 = (2 * p + 1) >> 2, i1 = (2 * p + 1) & 3; u32x4 w;
          w.x = pk2(g0 * o[d0][4 * i0], g0 * o[d0][4 * i0 + 1]); w.y = pk2(g0 * o[d0][4 * i0 + 2], g0 * o[d0][4 * i0 + 3]); w.z = pk2(g0 * o[d1][4 * i1], g0 * o[d1][4 * i1 + 1]); w.w = pk2(g0 * o[d1][4 * i1 + 2], g0 * o[d1][4 * i1 + 3]);
          *(u32x4*)(op + 8 * p) = w; } }
    unsigned long long um_lo = 0ull, um_hi = 0ull, wm_lo = 0ull, wm_hi = 0ull;
    { int tid = threadIdx.x; asm volatile("" : "+v"(tid)); const int lane = tid & 63, wave = __builtin_amdgcn_readfirstlane(tid >> 6);
      unsigned k0[8], k1[8], T[8]; const int m0 = lane, m1 = lane + 64;
#pragma unroll
      for (int it = 0; it < 8; ++it) { const int tk = 8 * wave + it;
          k0[it] = (m0 > qb) ? 0u : ((m0 == 0 || m0 == qb || m0 == qb - 1) ? 0xffffffffu : __float_as_uint(IMP[tk * 128 + m0]) + 1u);
          k1[it] = (m1 > qb) ? 0u : ((m1 == qb || m1 == qb - 1) ? 0xffffffffu : __float_as_uint(IMP[tk * 128 + m1]) + 1u); T[it] = 0u; }
      for (int bit = 31; bit >= 0; --bit) {
#pragma unroll
          for (int it = 0; it < 8; ++it) { const unsigned cand = T[it] | (1u << bit);
              const int cnt = __popcll(__ballot(k0[it] >= cand)) + __popcll(__ballot(k1[it] >= cand));
              if (cnt >= 16) T[it] = cand; } }
      const unsigned long long lt_mask = (1ull << lane) - 1ull, v0 = __ballot(m0 <= qb), v1 = __ballot(m1 <= qb);
#pragma unroll
      for (int it = 0; it < 8; ++it) { const int tk = 8 * wave + it; const unsigned Tt = T[it];
          const unsigned long long gt0 = __ballot(k0[it] > Tt), gt1 = __ballot(k1[it] > Tt), eq0 = __ballot(k0[it] == Tt), eq1 = __ballot(k1[it] == Tt);
          const int need = 16 - __popcll(gt0) - __popcll(gt1), ne0 = __popcll(eq0);
          const unsigned long long keep0 = __ballot(k0[it] == Tt && __popcll(eq0 & lt_mask) < need), keep1 = __ballot(k1[it] == Tt && (ne0 + __popcll(eq1 & lt_mask)) < need);
          if (lane == 0) { SELM[tk * 2] = (gt0 | keep0) & v0; SELM[tk * 2 + 1] = (gt1 | keep1) & v1; } }
      __syncthreads();
#pragma unroll
      for (int i = 0; i < 8; ++i) { wm_lo |= SELM[(8 * wave + i) * 2]; wm_hi |= SELM[(8 * wave + i) * 2 + 1]; }
      if (lane == 0) { WM[wave * 2] = wm_lo; WM[wave * 2 + 1] = wm_hi; }
      __syncthreads();
#pragma unroll
      for (int i = 0; i < 8; ++i) { um_lo |= WM[i * 2]; um_hi |= WM[i * 2 + 1]; }
      um_lo = __builtin_amdgcn_readfirstlane((unsigned)um_lo) | ((unsigned long long)__builtin_amdgcn_readfirstlane((unsigned)(um_lo >> 32)) << 32);
      um_hi = __builtin_amdgcn_readfirstlane((unsigned)um_hi) | ((unsigned long long)__builtin_amdgcn_readfirstlane((unsigned)(um_hi >> 32)) << 32);
      wm_lo = __builtin_amdgcn_readfirstlane((unsigned)wm_lo) | ((unsigned long long)__builtin_amdgcn_readfirstlane((unsigned)(wm_lo >> 32)) << 32);
      wm_hi = __builtin_amdgcn_readfirstlane((unsigned)wm_hi) | ((unsigned long long)__builtin_amdgcn_readfirstlane((unsigned)(wm_hi >> 32)) << 32); }
    { int tid = threadIdx.x; asm volatile("" : "+v"(tid)); const int lane = tid & 63, wave = __builtin_amdgcn_readfirstlane(tid >> 6), q = lane & 31, hi = lane >> 5;
      const int tl = 8 * wave + (q >> 2), head = 4 * g + (q & 3), t = 64 * qb + tl; const size_t trow = (size_t)b * SEQ + t;
      bf16x8 qf[8]; nsa_load_q(qf, T.Q, trow, head, hi);
      const unsigned long long sm_lo = SELM[tl * 2], sm_hi = SELM[tl * 2 + 1];
      float m = -1e30f, l = 0.f; f32x16 o[4];
#pragma unroll
      for (int db = 0; db < 4; ++db) o[db] = zero16();
      const float gsel = T.GATES[trow * 48 + head * 3 + 1];
      nsa_pass<2>(F, T.KS + (size_t)bg * SEQ * 128, T.VST + (size_t)bg * 128 * SEQ, SEQ, qb, 0, qb, um_lo, um_hi, wm_lo, wm_hi, sm_lo, sm_hi, qf, m, l, o, 0.f, tl, t, kr, vr, true, T.KW + (size_t)bg * SEQ * 128, T.VWT + (size_t)bg * 128 * SEQ, SEQ, max(0, qb - 8));
      const float lt = l + __shfl_xor(l, 32); const float c = lt > 0.f ? gsel / lt : 0.f;
      bf16* op = T.OS + trow * 2048 + head * 128 + 64 * hi;
#pragma unroll
      for (int p = 0; p < 8; ++p) { const int d0 = (2 * p) >> 2, i0 = (2 * p) & 3, d1 = (2 * p + 1) >> 2, i1 = (2 * p + 1) & 3; u32x4 w;
          w.x = pk2(c * o[d0][4 * i0], c * o[d0][4 * i0 + 1]); w.y = pk2(c * o[d0][4 * i0 + 2], c * o[d0][4 * i0 + 3]); w.z = pk2(c * o[d1][4 * i1], c * o[d1][4 * i1 + 1]); w.w = pk2(c * o[d1][4 * i1 + 2], c * o[d1][4 * i1 + 3]);
          *(u32x4*)(op + 8 * p) = w; } }
    { int tid = threadIdx.x; asm volatile("" : "+v"(tid)); const int lane = tid & 63, wave = __builtin_amdgcn_readfirstlane(tid >> 6), q = lane & 31, hi = lane >> 5;
      const int tl = 8 * wave + (q >> 2), head = 4 * g + (q & 3), t = 64 * qb + tl; const size_t trow = (size_t)b * SEQ + t;
      bf16x8 qf[8]; nsa_load_q(qf, T.Q, trow, head, hi);
      float m = -1e30f, l = 0.f; f32x16 o[4];
#pragma unroll
      for (int db = 0; db < 4; ++db) o[db] = zero16();
      const float gwin = T.GATES[trow * 48 + head * 3 + 2];
      nsa_pass<3>(F, T.KW + (size_t)bg * SEQ * 128, T.VWT + (size_t)bg * 128 * SEQ, SEQ, qb, max(0, qb - 8), qb, 0ull, 0ull, 0ull, 0ull, 0ull, 0ull, qf, m, l, o, 0.f, tl, t, kr, vr, true, nullptr, nullptr, 0, 0);
      const float lt = l + __shfl_xor(l, 32); const float c = lt > 0.f ? gwin / lt : 0.f;
      const size_t offp = trow * 2048 + head * 128 + 64 * hi, offo = trow * 2048 + head * 128 + 8 * hi;
      u32x4 av[8], sv[8];
#pragma unroll
      for (int p = 0; p < 8; ++p) { av[p] = *(const u32x4*)(T.OC + offp + 8 * p); sv[p] = *(const u32x4*)(T.OS + offp + 8 * p); }
#pragma unroll
      for (int p = 0; p < 8; ++p) { const int d0 = (2 * p) >> 2, i0 = (2 * p) & 3, d1 = (2 * p + 1) >> 2, i1 = (2 * p + 1) & 3; const u32x4 a = av[p], s2 = sv[p]; u32x2 wa, wb;
          wa.x = pk2(bflo(a.x) + bflo(s2.x) + c * o[d0][4 * i0], bfhi(a.x) + bfhi(s2.x) + c * o[d0][4 * i0 + 1]); wa.y = pk2(bflo(a.y) + bflo(s2.y) + c * o[d0][4 * i0 + 2], bfhi(a.y) + bfhi(s2.y) + c * o[d0][4 * i0 + 3]);
          wb.x = pk2(bflo(a.z) + bflo(s2.z) + c * o[d1][4 * i1], bfhi(a.z) + bfhi(s2.z) + c * o[d1][4 * i1 + 1]); wb.y = pk2(bflo(a.w) + bflo(s2.w) + c * o[d1][4 * i1 + 2], bfhi(a.w) + bfhi(s2.w) + c * o[d1][4 * i1 + 3]);
          { auto r = __builtin_amdgcn_permlane32_swap(wa.x, wb.x, false, false); wa.x = r[0]; wb.x = r[1]; }
          { auto r = __builtin_amdgcn_permlane32_swap(wa.y, wb.y, false, false); wa.y = r[0]; wb.y = r[1]; }
          u32x4 w; w.x = wa.x; w.y = wa.y; w.z = wb.x; w.w = wb.y;
          *(u32x4*)(T.O + offo + 16 * p) = w; } }
}
__device__ __forceinline__ void phase_nsa_attn(Frame& F, const Args& a) {
    unsigned char* ws = F.ws_;
    const NsaT T{(const bf16*)(ws + WS_MIX + MY_Q), (const bf16*)(ws + WS_MIX + MY_KCMP), (const bf16*)(ws + WS_MIX + MY_VCT), (const bf16*)(ws + WS_MIX + MY_KS), (const bf16*)(ws + WS_MIX + MY_VST),
                 (const bf16*)(ws + WS_MIX + MY_KW), (const bf16*)(ws + WS_MIX + MY_VWT), (const float*)(ws + WS_MIX + MY_GATES), (bf16*)(ws + WS_MIX + MY_ONSA), (bf16*)(ws + WS_XG), (bf16*)(ws + WS_XG + 64 * MiB)};
    const int bgi = F.vcu >> 5, s = F.vcu & 31;
    for (int i = 0; i < 4; ++i) { const int qb = (i == 0) ? s : (i == 1) ? 63 - s : (i == 2) ? 64 + s : 127 - s;
        if (bgi < 8) nsa_unit(F, T, bgi >> 2, bgi & 3, qb);
#if MOE_CVT_IN_ATTN
        if (i == (s & 3)) { __syncthreads(); tr_moe_layer(F, a, 1); __syncthreads(); }
#endif
    }
}
constexpr int NPL = 11, NPHASE = 1 + 2 * NPL;
#ifndef REPEAT_MASK
#define REPEAT_MASK 0ull
#endif
#define IN(k) for (int rep_ = 0, nrep_ = ((lo <= (k) && (k) < hi) ? 1 + (int)((REPEAT_MASK >> (k)) & 1ull) : 0); rep_ < nrep_ && frame_refresh(F, args.wsbase); ++rep_)
#define ws F.ws_
#define SEAM(k) do { if ((k) + 1 < hi) xcd_barrier(bar); } while (0)
template <int layer> __device__ __forceinline__ void layer_phases(Frame& F, const Args& args, const XcdBarrier& bar, const int lo, const int hi) {
        const int pb = 1 + layer * NPL;
        IN((pb + 0)) {
            if constexpr (layer == 0) {
                pg8::Gemm g{(const bf16*)(ws + WS_XB), (const bf16*)(ws + WS_WIN0T), NTOK, EVEN_IN_PAD, DM}; pg8::StaticOrder S; S.init(NTOK, EVEN_IN_PAD, F.G, (int)blockIdx.x);
                pg8::EpiIn0 E{(bf16*)(ws + WS_MIX + MX_Q), (bf16*)(ws + WS_MIX + MX_K), (bf16*)(ws + WS_MIX + MX_V), (bf16*)(ws + WS_MIX + MX_Z), (bf16*)(ws + WS_MIX + MX_XBC), (float*)(ws + WS_MIX + MX_DT), 0.125f * LOG2E};
                pg8::gemm_phase<pg8::EpiIn0, pg8::StaticOrder, true, true>(F.lds, g, S, E);
            } else {
                pg8::Gemm g{(const bf16*)(ws + WS_XB), (const bf16*)(ws + WS_WIN1T), NTOK, ODD_MAIN, DM}; pg8::StaticOrder S; S.init(NTOK, ODD_MAIN, F.G, (int)blockIdx.x);
                pg8::EpiIn1 E{(bf16*)(ws + WS_MIX + MY_Q), (bf16*)(ws + WS_MIX + MY_KC), (bf16*)(ws + WS_MIX + MY_VC), (bf16*)(ws + WS_MIX + MY_KS), (bf16*)(ws + WS_MIX + MY_VST), (bf16*)(ws + WS_MIX + MY_KW), (bf16*)(ws + WS_MIX + MY_VWT),
                              0.08838834764831845f * LOG2E};
                pg8::gemm_phase<pg8::EpiIn1, pg8::StaticOrder, true, true>(F.lds, g, S, E);
            }
            SEAM(pb + 0);
        }
        if constexpr (layer == 0) {
#if ENABLE_MIX0
            IN((pb + 1)) {
                phase_diffattn(F, args, (const bf16*)(ws + WS_MIX + MX_Q), (const bf16*)(ws + WS_MIX + MX_K), (const bf16*)(ws + WS_MIX + MX_V), (bf16*)(ws + WS_MIX + MX_OV));
                const SsdIn I{(const bf16*)(ws + WS_MIX + MX_XBC), (const float*)(ws + WS_MIX + MX_DT), args.in[10], args.in[11], args.in[12], args.in[13]};
                phase_ssd_states(F, I, (bf16*)(ws + WS_MIX + MX_ST), (float*)(ws + WS_MIX + MX_CDEC));
                SEAM(pb + 1);
            }
            IN((pb + 2)) { phase_ssd_scan(F, (bf16*)(ws + WS_MIX + MX_ST), (const float*)(ws + WS_MIX + MX_CDEC)); SEAM(pb + 2); }
            IN((pb + 3)) {
                const SsdIn I{(const bf16*)(ws + WS_MIX + MX_XBC), (const float*)(ws + WS_MIX + MX_DT), args.in[10], args.in[11], args.in[12], args.in[13]};
                phase_ssd_out(F, I, (const bf16*)(ws + WS_MIX + MX_ST), (const bf16*)(ws + WS_MIX + MX_Z), args.in[14], (bf16*)(ws + WS_MIX + MX_YSRAW));
                SEAM(pb + 3);
            }
            IN((pb + 4)) { phase_post0(F, args, (const bf16*)(ws + WS_MIX + MX_OV), (const bf16*)(ws + WS_MIX + MX_YSRAW), (bf16*)(ws + WS_MIX + MX_YMIX)); SEAM(pb + 4); }
#endif
        } else {
#if ENABLE_MIX1
            IN((pb + 1)) { phase_nsa_prep(F, args); SEAM(pb + 1); }
            IN((pb + 2)) { phase_nsa_attn(F, args); SEAM(pb + 2); }
#endif
        }
        IN((pb + 5)) {
            const bf16* A = (layer == 0) ? (const bf16*)(ws + (ENABLE_MIX0 ? WS_MIX + MX_YMIX : WS_END)) : (const bf16*)(ws + (ENABLE_MIX1 ? WS_MIX + MY_ONSA : WS_END)); const bf16* Bt = (const bf16*)(ws + (layer == 0 ? WS_WOUT0T : WS_WOUT1T));
            pg8::Gemm g{A, Bt, NTOK, DM, DM}; pg8::StaticOrder S; S.init(NTOK, DM, F.G, (int)blockIdx.x);
            if constexpr (layer == 0) { pg8::EpiOut E{args.in[0], (bf16*)(ws + WS_R), ALPHA}; pg8::gemm_phase<pg8::EpiOut, pg8::StaticOrder, true, true>(F.lds, g, S, E); }
            else { pg8::EpiOutB E{(const bf16*)(ws + WS_XB), (bf16*)(ws + WS_R), ALPHA}; pg8::gemm_phase<pg8::EpiOutB, pg8::StaticOrder, true, true>(F.lds, g, S, E); }
            SEAM(pb + 5);
        }
        IN((pb + 6)) { phase_ln1_router(F, args, layer); SEAM(pb + 6); }
        IN((pb + 7)) { phase_permute(F, args, layer); SEAM(pb + 7); }
        IN((pb + 8)) {
#if !ONE_LAUNCH
            moe_tables(F, layer);
#endif
            pg8::MoeOrder S{(const LAS int*)(F.lds + MOE_TAB_OFF), F.G, (int)blockIdx.x};
            pg8::EpiMoe1 E{(bf16*)(ws + WS_HID)};
#if MOE_GATHER
            moe_gather_table(F, S, (const int*)(ws + WS_TOK + 3 * 131072));
            pg8::Gemm g{(const bf16*)(ws + WS_HB), (const bf16*)(ws + WS_MOEB1 + (size_t)layer * 256 * MiB), XG_ROWS, NEXP * 2048, DM};
            pg8::gemm_phase<pg8::EpiMoe1, pg8::MoeOrder, true, true, true>(F.lds, g, S, E, (const LAS unsigned*)(F.lds + GTAB_OFF));
#else
            pg8::Gemm g{(const bf16*)(ws + WS_XG), (const bf16*)(ws + WS_MOEB1 + (size_t)layer * 256 * MiB), XG_ROWS, NEXP * 2048, DM};
            pg8::gemm_phase<pg8::EpiMoe1, pg8::MoeOrder, true, true>(F.lds, g, S, E);
#endif
            SEAM(pb + 8);
        }
        IN((pb + 9)) {
#if !ONE_LAUNCH
            moe_tables(F, layer);
#endif
            pg8::Gemm g{(const bf16*)(ws + WS_HID), (const bf16*)(ws + WS_MOEB2 + (size_t)layer * 128 * MiB), XG_ROWS, NEXP * 2048, MOE_FF};
            pg8::MoeOrder S{(const LAS int*)(F.lds + MOE_TAB_OFF), F.G, (int)blockIdx.x};
            moe_rowmap_table(F, S, (const int*)(ws + WS_TOK + 3 * 131072), (const float*)(ws + WS_TOK + 3 * 131072 + XG_ROWS * 4));
            pg8::EpiMoe2 E{(bf16*)(ws + WS_FOUT), (const LAS int*)(F.lds + RT_OFF), (const LAS float*)(F.lds + RW_OFF)};
            pg8::gemm_phase<pg8::EpiMoe2, pg8::MoeOrder, true, true>(F.lds, g, S, E);
            SEAM(pb + 9);
        }
        IN((pb + 10)) { phase_ln2(F, args, layer); SEAM(pb + 10); }
    }
__global__ void __launch_bounds__(NTHR, 2) mega(Args args) {
    extern __shared__ __attribute__((aligned(16))) unsigned char lds_raw[];
    Frame F;
    F.lds = (LAS unsigned char*)lds_raw;
    F.MISC = (volatile LAS unsigned*)(F.lds + MISC_OFF);
    F.tid = threadIdx.x; F.lane = F.tid & 63; F.wave = __builtin_amdgcn_readfirstlane(F.tid >> 6);
    F.G = gridDim.x; { const int bx = blockIdx.x; F.vcu = (F.G % 8 == 0) ? (bx % 8) * (F.G / 8) + bx / 8 : bx; }
    F.ws_ = args.wsbase; F.ctl = (gu32*)(args.wsbase + WS_CTL);
    for (int u = F.tid; u < (LDS_BYTES - LDSCTL_OFF) / 4; u += NTHR) ((LAS unsigned*)(F.lds + LDSCTL_OFF))[u] = 0u;
    __syncthreads();
    const int lo = args.ph_lo, hi = args.ph_hi;
    const bool multi = (hi - lo) > 1;
    XcdBarrier bar; bar.bar = (unsigned*)(F.ctl + CW_BAR); bar.x = 0; bar.st = nullptr;
    if (multi) bar = xcd_barrier_post((unsigned*)(F.ctl + CW_BAR), F.MISC + 8);
    IN((0)) { phase_prologue(F, args); SEAM(0); }

    layer_phases<0>(F, args, bar, lo, hi);
    layer_phases<1>(F, args, bar, lo, hi);
#undef IN
#undef SEAM
#undef ws
}

extern "C" void kernel_launch(void* const* d_in, const int* in_sizes, int n_in, void* d_out, int out_size, void* d_ws, size_t ws_size, hipStream_t stream) {
    static int grid = 0;
    if (grid == 0) {
        if (n_in != 31 || in_sizes[0] != NTOK * DM || out_size != NTOK * DM || ws_size < WS_END) {
            fprintf(stderr, "kernel_launch: unexpected problem: n_in %d in0 %d out %d ws %zu (need %zu); nothing launched\n", n_in, n_in > 0 ? in_sizes[0] : -1, out_size, ws_size, (size_t)WS_END); grid = -1; return; }
        int dev = 0, cus = 0, per_cu = 0;
        if (hipGetDevice(&dev) != hipSuccess || hipDeviceGetAttribute(&cus, hipDeviceAttributeMultiprocessorCount, dev) != hipSuccess) { grid = -1; return; }
        if (hipFuncSetAttribute((const void*)mega, hipFuncAttributeMaxDynamicSharedMemorySize, LDS_BYTES) != hipSuccess) { fprintf(stderr, "kernel_launch: hipFuncSetAttribute failed\n"); grid = -1; return; }
        if (hipOccupancyMaxActiveBlocksPerMultiprocessor(&per_cu, (const void*)mega, NTHR, LDS_BYTES) != hipSuccess || per_cu < 1) fprintf(stderr, "kernel_launch: occupancy query reports %d\n", per_cu);
        (void)hipGetLastError();
        grid = 256;
        if (cus != 256) fprintf(stderr, "kernel_launch: device reports %d CUs; built for 256\n", cus);
    }
    if (grid < 0) return;
    (void)hipMemsetAsync((char*)d_ws + WS_CTL, 0, CTL_ZERO_BYTES, stream);
#if !ENABLE_MIX0 || !ENABLE_MIX1
    if (ws_size >= WS_END + 64 * MiB) (void)hipMemsetAsync((char*)d_ws + WS_END, 0, 64 * MiB, stream);
#endif
    Args a{};
    for (int i = 0; i < 31; ++i) a.in[i] = (const float*)d_in[i];
    a.out = (float*)d_out; a.wsbase = (unsigned char*)d_ws;
#if ONE_LAUNCH
    a.ph_lo = 0; a.ph_hi = NPHASE;
    hipLaunchKernelGGL(mega, dim3(grid), dim3(NTHR), LDS_BYTES, stream, a);
#else
    for (int p = 0; p < NPHASE; ++p) {
        const int k = (p - 1) % NPL, layer = (p - 1) / NPL;
        if (p > 0 && !PHASE_ACTIVE(layer, k)) continue;
        a.ph_lo = p; a.ph_hi = p + 1;
        hipLaunchKernelGGL(mega, dim3(grid), dim3(NTHR), LDS_BYTES, stream, a);
    }
#endif
}
```
